# Optimizing an MI355X kernel written in HIP

```python
import jax, jax.numpy as jnp
from jax import lax
import numpy as np

D_MODEL = 2048
BATCH = 2
SEQ = 4096
DEPTH = 1

ATTN_HEADS = 8
HEAD_DIM = 128
ATTN_WIDTH = ATTN_HEADS * HEAD_DIM
CONV_WIDTH = D_MODEL // 2
CONV_K = 3
MOBA_BLOCK = 256
MOBA_TOP_K = 3
QUERY_CHUNK = 64
D_FF = 4 * D_MODEL
PLE_DIM = 256
RMS_EPS = 1e-6
IN_SIZES = (ATTN_WIDTH, ATTN_WIDTH, ATTN_WIDTH, CONV_WIDTH, CONV_WIDTH, CONV_WIDTH, D_MODEL, D_MODEL)
IN_COLS = sum(IN_SIZES)

kernel_name = 'hybrid_moba_shortconv_block'


def rms_norm(x, g):
    xf = x.astype(jnp.float32)
    y = xf * lax.rsqrt(jnp.mean(xf * xf, axis=-1, keepdims=True) + RMS_EPS)
    return (y * g.astype(jnp.float32)).astype(x.dtype)


def moba_attention(q, k, v):
    B, H, S, hd = q.shape
    dt = q.dtype
    f32 = jnp.float32
    nb = -(-S // MOBA_BLOCK)
    pad = nb * MOBA_BLOCK - S
    kb = jnp.pad(k, ((0, 0), (0, 0), (0, pad), (0, 0))).reshape(B, H, nb, MOBA_BLOCK, hd)
    vb = jnp.pad(v, ((0, 0), (0, 0), (0, pad), (0, 0))).reshape(B, H, nb, MOBA_BLOCK, hd)
    q_blk = jnp.arange(S) // MOBA_BLOCK
    n_sel = min(MOBA_TOP_K, nb - 1)
    scale = HEAD_DIM ** -0.5
    if n_sel > 0:
        k_mean = jnp.mean(kb.astype(f32), axis=3)
        gate = jnp.einsum('bhsd,bhnd->bhsn', q.astype(f32), k_mean)
        past = jnp.arange(nb)[None, :] < q_blk[:, None]
        gate = jnp.where(past[None, None], gate, -jnp.inf)
        _, sel = lax.top_k(gate, n_sel)
        sel_valid = jnp.arange(n_sel)[None, :] < q_blk[:, None]
    bi = jnp.arange(B)[:, None, None, None]
    hi = jnp.arange(H)[None, :, None, None]

    def chunk(c):
        q0 = c * QUERY_CHUNK
        qc = lax.dynamic_slice_in_dim(q, q0, QUERY_CHUNK, axis=2)
        qpos = q0 + jnp.arange(QUERY_CHUNK)
        blk = q0 // MOBA_BLOCK
        k_own = lax.dynamic_index_in_dim(kb, blk, axis=2, keepdims=False)
        v_own = lax.dynamic_index_in_dim(vb, blk, axis=2, keepdims=False)
        kpos = blk * MOBA_BLOCK + jnp.arange(MOBA_BLOCK)
        s_own = jnp.einsum('bhqd,bhkd->bhqk', qc, k_own, preferred_element_type=f32) * scale
        s_own = jnp.where((kpos[None, :] <= qpos[:, None])[None, None], s_own, -jnp.inf)
        if n_sel > 0:
            sel_c = lax.dynamic_slice_in_dim(sel, q0, QUERY_CHUNK, axis=2)
            val_c = lax.dynamic_slice_in_dim(sel_valid, q0, QUERY_CHUNK, axis=0)
            k_sel = kb[bi, hi, sel_c]
            v_sel = vb[bi, hi, sel_c]
            s_sel = jnp.einsum('bhqd,bhqnkd->bhqnk', qc, k_sel, preferred_element_type=f32) * scale
            s_sel = jnp.where(val_c[None, None, :, :, None], s_sel, -jnp.inf)
            s = jnp.concatenate([s_sel.reshape(B, H, QUERY_CHUNK, n_sel * MOBA_BLOCK), s_own], axis=-1)
            probs = jax.nn.softmax(s, axis=-1)
            p_sel = probs[..., :n_sel * MOBA_BLOCK].reshape(B, H, QUERY_CHUNK, n_sel, MOBA_BLOCK)
            p_own = probs[..., n_sel * MOBA_BLOCK:]
            o = (jnp.einsum('bhqnk,bhqnkd->bhqd', p_sel.astype(dt), v_sel, preferred_element_type=f32)
                 + jnp.einsum('bhqk,bhkd->bhqd', p_own.astype(dt), v_own, preferred_element_type=f32))
        else:
            probs = jax.nn.softmax(s_own, axis=-1)
            o = jnp.einsum('bhqk,bhkd->bhqd', probs.astype(dt), v_own, preferred_element_type=f32)
        return o.astype(dt)

    out = lax.map(chunk, jnp.arange(S // QUERY_CHUNK))
    return out.transpose(1, 2, 0, 3, 4).reshape(B, H, S, hd)


def causal_depthwise_conv(u, w):
    C = u.shape[-1]
    return lax.conv_general_dilated(
        u, w[:, None, :].astype(u.dtype), window_strides=(1,), padding=[(CONV_K - 1, 0)],
        dimension_numbers=('NWC', 'WIO', 'NWC'), feature_group_count=C)


def setup_inputs(seed: int = 0) -> dict:
    key = jax.random.key(seed)
    ks = jax.random.split(key, 16)
    f32 = jnp.float32

    def nrm(k, shape, scale):
        return jax.random.normal(k, shape, f32) * scale

    def gain(k, shape):
        return 1.0 + 0.05 * jax.random.normal(k, shape, f32)

    return {
        'x': nrm(ks[0], (BATCH, SEQ, D_MODEL), 1.0),
        'p': nrm(ks[1], (DEPTH, BATCH, SEQ, PLE_DIM), 1.0),
        'g_mix': gain(ks[2], (DEPTH, D_MODEL)),
        'w_in': nrm(ks[3], (DEPTH, D_MODEL, IN_COLS), D_MODEL ** -0.5),
        'g_q': gain(ks[4], (DEPTH, HEAD_DIM)),
        'g_k': gain(ks[5], (DEPTH, HEAD_DIM)),
        'w_conv': nrm(ks[6], (DEPTH, CONV_K, CONV_WIDTH), CONV_K ** -0.5),
        'w_attn_out': nrm(ks[7], (DEPTH, ATTN_WIDTH, D_MODEL), ATTN_WIDTH ** -0.5),
        'w_conv_out': nrm(ks[8], (DEPTH, CONV_WIDTH, D_MODEL), CONV_WIDTH ** -0.5),
        'w_o': nrm(ks[9], (DEPTH, D_MODEL, D_MODEL), D_MODEL ** -0.5),
        'g_mlp': gain(ks[10], (DEPTH, D_MODEL)),
        'w_up': nrm(ks[11], (DEPTH, D_MODEL, D_FF), D_MODEL ** -0.5),
        'w_down': nrm(ks[12], (DEPTH, D_FF, D_MODEL), D_FF ** -0.5),
        'g_ple': gain(ks[13], (DEPTH, D_MODEL)),
        'w_ple_gate': nrm(ks[14], (DEPTH, D_MODEL, D_MODEL), D_MODEL ** -0.5),
        'w_ple_proj': nrm(ks[15], (DEPTH, PLE_DIM, D_MODEL), PLE_DIM ** -0.5),
    }


def reference(x, p, g_mix, w_in, g_q, g_k, w_conv, w_attn_out, w_conv_out, w_o,
              g_mlp, w_up, w_down, g_ple, w_ple_gate, w_ple_proj):
    B, S, D = x.shape
    cuts = [int(c) for c in np.cumsum(IN_SIZES)[:-1]]
    r = x
    for i in range(DEPTH):
        h = rms_norm(r, g_mix[i])
        z = h @ w_in[i]
        q, k, v, c_b, c_c, c_x, g_a, g_c = jnp.split(z, cuts, axis=-1)
        q = rms_norm(q.reshape(B, S, ATTN_HEADS, HEAD_DIM), g_q[i]).transpose(0, 2, 1, 3)
        k = rms_norm(k.reshape(B, S, ATTN_HEADS, HEAD_DIM), g_k[i]).transpose(0, 2, 1, 3)
        v = v.reshape(B, S, ATTN_HEADS, HEAD_DIM).transpose(0, 2, 1, 3)
        attn = moba_attention(q, k, v)
        y_attn = attn.transpose(0, 2, 1, 3).reshape(B, S, ATTN_WIDTH) @ w_attn_out[i]
        y_conv = (c_b * causal_depthwise_conv(c_c * c_x, w_conv[i])) @ w_conv_out[i]
        merged = jax.nn.sigmoid(g_a) * y_attn + jax.nn.sigmoid(g_c) * y_conv
        r = r + merged @ w_o[i]
        h = rms_norm(r, g_mlp[i])
        r = r + jnp.square(jax.nn.relu(h @ w_up[i])) @ w_down[i]
        h = rms_norm(r, g_ple[i])
        r = r + jax.nn.sigmoid(h @ w_ple_gate[i]) * (p[i] @ w_ple_proj[i])
    return r
```

```cpp
#include <hip/hip_runtime.h>
#include <hip/hip_cooperative_groups.h>
#include <cstdio>
#include <cstdint>
namespace cg = cooperative_groups;

#define LAS __attribute__((address_space(3)))
#define GAS __attribute__((address_space(1)))
typedef unsigned short bf16_t;
typedef short bf16x8 __attribute__((ext_vector_type(8)));
typedef float f32x4 __attribute__((ext_vector_type(4)));
typedef float f32x2 __attribute__((ext_vector_type(2)));
typedef float f32x16 __attribute__((ext_vector_type(16)));
typedef unsigned u32x4 __attribute__((ext_vector_type(4)));
typedef unsigned u32x2 __attribute__((ext_vector_type(2)));

constexpr int BATCH = 2, SEQ = 4096, M = BATCH * SEQ, D = 2048, NH = 8, HD = 128, AW = 1024, CW = 1024, FF = 8192, PLE = 256;
constexpr int NZ = 10240, MOBA_BLK = 256, NBLK = SEQ / MOBA_BLK, TOPK = 3;
constexpr float RMS_EPS = 1e-6f;
constexpr float LOG2E = 1.4426950408889634f;
constexpr float QSCALE = 0.08838834764831845f * LOG2E;
constexpr int NWAVES = 8, NTHREADS = 512;
constexpr int LDS_BYTES = 147456;

constexpr size_t MiB = 1u << 20;
constexpr size_t WS_Q = 0 * MiB, WS_K = 16 * MiB, WS_CB = 32 * MiB, WS_SA = 48 * MiB, WS_SC = 80 * MiB, WS_V = 112 * MiB, WS_CC = 128 * MiB, WS_CX = 144 * MiB;
constexpr size_t WS_HB = 160 * MiB;
constexpr size_t WS_VT = 176 * MiB;
constexpr size_t WS_T1 = 112 * MiB;
constexpr size_t WS_R1B = 160 * MiB;
constexpr size_t WS_ACT = 0 * MiB;
constexpr size_t WS_R2B = 128 * MiB;
constexpr size_t WS_T2 = 0 * MiB;
constexpr size_t WS_WIN = 192 * MiB, WS_WUP = 232 * MiB, WS_WDN = 264 * MiB, WS_WO = 296 * MiB, WS_WG = 304 * MiB, WS_WAO = 312 * MiB, WS_WCO = 316 * MiB, WS_WPP = 320 * MiB;
constexpr size_t WS_MERGED = 192 * MiB;
constexpr size_t WS_PB = 321 * MiB;
constexpr size_t WS_ST1 = 325 * MiB;
constexpr size_t WS_ST2 = WS_ST1 + 256 * 1024;
constexpr size_t WS_KMEAN = WS_ST2 + 256 * 1024;
constexpr size_t WS_CTL = 326 * MiB, CTL_ZERO_BYTES = 16384;
constexpr size_t WS_END = 327 * MiB;

__device__ __forceinline__ unsigned cvt_pk_bf16(float lo, float hi) { unsigned r; asm volatile("v_cvt_pk_bf16_f32 %0, %1, %2" : "=v"(r) : "v"(lo), "v"(hi)); return r; }
__device__ __forceinline__ int lane_id_asm() { int l; asm volatile("v_mbcnt_lo_u32_b32 %0, -1, 0\n\tv_mbcnt_hi_u32_b32 %0, -1, %0" : "=v"(l)); return l; }
__device__ __forceinline__ float bf_lo(unsigned u) { return __uint_as_float(u << 16); }
__device__ __forceinline__ float bf_hi(unsigned u) { return __uint_as_float(u & 0xffff0000u); }
__device__ __forceinline__ float sigmoidf_fast(float x) { return __builtin_amdgcn_rcpf(1.0f + __builtin_amdgcn_exp2f(-x * LOG2E)); }

namespace pg8 {
constexpr int BM = 256, BK = 64, HALF = 128, HTB = HALF * BK * 2  , STAGE_BYTES = 8 * HTB, NXCD = 8, WGM = 8;
__host__ __device__ __forceinline__ int lds_byte(int r, int c) { const int st = (r >> 4) * 2 + (c >> 5), rr = r & 15, cc = c & 31, ob = rr * 64 + cc * 2; return st * 1024 + (ob ^ (((ob >> 9) & 1) << 5)); }
__host__ __device__ __forceinline__ void stage_rc(int b, int& R, int& C) { const int st = b / 1024, sb = b % 1024, swz = sb ^ (((sb >> 9) & 1) << 5); R = (st >> 1) * 16 + swz / 64; C = (st & 1) * 32 + (swz % 64) / 2; }
__host__ __device__ __forceinline__ int perm32(int rho) { const int n = rho >> 4, i = rho & 15; return 8 * (i >> 2) + 4 * n + (i & 3); }

struct Unit { int pm, pn; };
struct Gemm { const bf16_t* A; const bf16_t* Bt; int M, N, K; };

struct StaticOrder {
    int nM, nN, nwg, G, c;
    __host__ __device__ void init(int M_, int N_, int G_, int c_) { nM = M_ / BM; nN = N_ / BM; nwg = nM * nN; G = G_; c = c_; }
    __host__ __device__ bool next(int i, Unit& u) const {
        const long L = (long)i * G + c; if (L >= nwg) return false;
        int wgid = (int)L; { const int q = nwg / NXCD, r = nwg % NXCD, xcd = wgid % NXCD, off = wgid / NXCD; wgid = (xcd < r ? xcd * (q + 1) : r * (q + 1) + (xcd - r) * q) + off; }
        const int nig = WGM * nN, gid = wgid / nig, fm = gid * WGM, gsz = (nM - fm) < WGM ? (nM - fm) : WGM;
        u.pm = fm + ((wgid % nig) % gsz); u.pn = (wgid % nig) / gsz; return true;
    }
    __device__ __forceinline__ void a_ready(const Unit&) const {}
    __device__ __forceinline__ void done(const Unit&) const {}
};

typedef f32x4 Acc[2][2][4][2];

struct EpiZ {
    static constexpr bool PERM = true, AFTER_DRAIN = false;
    unsigned char* ws;
    __device__ __forceinline__ void operator()(const Acc& acc, const Unit& u, int wr, int wc, int fr, int fq) const {
        const int pn = u.pn; const int seg = pn < 24 ? (pn >> 2) : (pn < 32 ? 6 : 7);
        const size_t boff = seg == 0 ? WS_Q : seg == 1 ? WS_K : seg == 2 ? WS_V : seg == 3 ? WS_CB : seg == 4 ? WS_CC : seg == 5 ? WS_CX : seg == 6 ? WS_SA : WS_SC;
        const int ldc = seg < 6 ? 1024 : 2048; const int colt = seg < 6 ? (pn & 3) * 256 : ((pn - 24) & 7) * 256; const bool sg = seg >= 6;
        bf16_t* base = (bf16_t*)(ws + boff);
        const int row0 = u.pm * BM + wr * 64 + fr, col0 = colt + wc * 32 + 8 * fq;
#pragma unroll
        for (int ai = 0; ai < 2; ++ai)
#pragma unroll
            for (int m = 0; m < 4; ++m) { bf16_t* rowp = base + (size_t)(row0 + ai * HALF + m * 16) * ldc + col0;
#pragma unroll
                for (int bj = 0; bj < 2; ++bj) { f32x4 v0 = acc[ai][bj][m][0], v1 = acc[ai][bj][m][1];
                    if (sg) {
#pragma unroll
                        for (int j = 0; j < 4; ++j) { v0[j] = sigmoidf_fast(v0[j]); v1[j] = sigmoidf_fast(v1[j]); } }
                    u32x4 w; w.x = cvt_pk_bf16(v0[0], v0[1]); w.y = cvt_pk_bf16(v0[2], v0[3]); w.z = cvt_pk_bf16(v1[0], v1[1]); w.w = cvt_pk_bf16(v1[2], v1[3]);
                    *(u32x4*)(rowp + bj * HALF) = w; } }
    }
};
struct EpiConvPart {
    static constexpr bool PERM = true, AFTER_DRAIN = false;
    const bf16_t* sc; bf16_t* t1;
    __device__ __forceinline__ void operator()(const Acc& acc, const Unit& u, int wr, int wc, int fr, int fq) const {
        const int row0 = u.pm * BM + wr * 64 + fr, col0 = u.pn * BM + wc * 32 + 8 * fq;
#pragma unroll
        for (int ai = 0; ai < 2; ++ai)
#pragma unroll
            for (int m = 0; m < 4; ++m) { const size_t off = (size_t)(row0 + ai * HALF + m * 16) * D + col0;
#pragma unroll
                for (int bj = 0; bj < 2; ++bj) { const u32x4 g = *(const u32x4*)(sc + off + bj * HALF);
                    f32x4 v0 = acc[ai][bj][m][0], v1 = acc[ai][bj][m][1];
                    v0[0] *= bf_lo(g.x); v0[1] *= bf_hi(g.x); v0[2] *= bf_lo(g.y); v0[3] *= bf_hi(g.y); v1[0] *= bf_lo(g.z); v1[1] *= bf_hi(g.z); v1[2] *= bf_lo(g.w); v1[3] *= bf_hi(g.w);
                    u32x4 w; w.x = cvt_pk_bf16(v0[0], v0[1]); w.y = cvt_pk_bf16(v0[2], v0[3]); w.z = cvt_pk_bf16(v1[0], v1[1]); w.w = cvt_pk_bf16(v1[2], v1[3]);
                    *(u32x4*)(t1 + off + bj * HALF) = w; }
                if (m & 1) asm volatile("" ::: "memory"); }
    }
};
struct EpiMerged {
    static constexpr bool PERM = true, AFTER_DRAIN = false;
    const bf16_t* sa; const bf16_t* t1; bf16_t* out;
    __device__ __forceinline__ void operator()(const Acc& acc, const Unit& u, int wr, int wc, int fr, int fq) const {
        const int row0 = u.pm * BM + wr * 64 + fr, col0 = u.pn * BM + wc * 32 + 8 * fq;
#pragma unroll
        for (int ai = 0; ai < 2; ++ai)
#pragma unroll
            for (int m = 0; m < 4; ++m) { const size_t off = (size_t)(row0 + ai * HALF + m * 16) * D + col0;
#pragma unroll
                for (int bj = 0; bj < 2; ++bj) { const u32x4 g = *(const u32x4*)(sa + off + bj * HALF);
                    const u32x4 tw = *(const u32x4*)(t1 + off + bj * HALF); const f32x4 a0 = (f32x4){bf_lo(tw.x), bf_hi(tw.x), bf_lo(tw.y), bf_hi(tw.y)}, a1 = (f32x4){bf_lo(tw.z), bf_hi(tw.z), bf_lo(tw.w), bf_hi(tw.w)};
                    f32x4 v0 = acc[ai][bj][m][0], v1 = acc[ai][bj][m][1];
                    v0[0] = v0[0] * bf_lo(g.x) + a0[0]; v0[1] = v0[1] * bf_hi(g.x) + a0[1]; v0[2] = v0[2] * bf_lo(g.y) + a0[2]; v0[3] = v0[3] * bf_hi(g.y) + a0[3];
                    v1[0] = v1[0] * bf_lo(g.z) + a1[0]; v1[1] = v1[1] * bf_hi(g.z) + a1[1]; v1[2] = v1[2] * bf_lo(g.w) + a1[2]; v1[3] = v1[3] * bf_hi(g.w) + a1[3];
                    u32x4 w; w.x = cvt_pk_bf16(v0[0], v0[1]); w.y = cvt_pk_bf16(v0[2], v0[3]); w.z = cvt_pk_bf16(v1[0], v1[1]); w.w = cvt_pk_bf16(v1[2], v1[3]);
                    *(u32x4*)(out + off + bj * HALF) = w; }
                if (m & 1) asm volatile("" ::: "memory"); }
    }
};
template <bool BASE_BF16> struct EpiResid {
    static constexpr bool PERM = false, AFTER_DRAIN = true;
    const void* base; bf16_t* rb; float* stats;
    __device__ __forceinline__ void fused(Acc& acc, const Unit& u, int wr, int wc, int fr, int fq, LAS unsigned char* lds, int wid, int lane) const {
        LAS float* P = (LAS float*)lds;
        const int col0 = u.pn * BM + wc * 32 + 4 * fq;
#pragma unroll
        for (int ai = 0; ai < 2; ++ai)
#pragma unroll
            for (int m = 0; m < 4; ++m) { const int rl = ai * HALF + wr * 64 + m * 16 + fr; const size_t off = (size_t)(u.pm * BM + rl) * D + col0; float s = 0.f;
#pragma unroll
                for (int bj = 0; bj < 2; ++bj)
#pragma unroll
                    for (int n = 0; n < 2; ++n) { f32x4 b;
                        if (BASE_BF16) { const u32x2 bw = *(const u32x2*)((const bf16_t*)base + off + bj * HALF + n * 16); b = (f32x4){bf_lo(bw.x), bf_hi(bw.x), bf_lo(bw.y), bf_hi(bw.y)}; }
                        else b = *(const f32x4*)((const float*)base + off + bj * HALF + n * 16);
                        const f32x4 v = acc[ai][bj][m][n] + b;
                        u32x2 w; w.x = cvt_pk_bf16(v[0], v[1]); w.y = cvt_pk_bf16(v[2], v[3]); *(u32x2*)(rb + off + bj * HALF + n * 16) = w;
                        s += (v[0] * v[0] + v[1] * v[1]) + (v[2] * v[2] + v[3] * v[3]); }
                s += __shfl_xor(s, 16); s += __shfl_xor(s, 32);
                if (fq == 0) P[rl * 4 + wc] = s;
                asm volatile("" ::: "memory"); }
        __syncthreads();
        const int t = wid * 64 + lane;
        if (t < 256) { const float s = (P[t * 4 + 0] + P[t * 4 + 1]) + (P[t * 4 + 2] + P[t * 4 + 3]); stats[(size_t)(u.pm * BM + t) * 8 + u.pn] = s; }
        __syncthreads();
    }
};
__device__ __forceinline__ float row_rstd(const float* stats, int row) {
    const f32x4 a = *(const f32x4*)(stats + (size_t)row * 8), b = *(const f32x4*)(stats + (size_t)row * 8 + 4);
    const float s = ((a[0] + a[1]) + (a[2] + a[3])) + ((b[0] + b[1]) + (b[2] + b[3]));
    return __builtin_amdgcn_rsqf(s * (1.0f / D) + RMS_EPS);
}
struct EpiUp {
    static constexpr bool PERM = true, AFTER_DRAIN = false;
    const float* stats; bf16_t* out;
    __device__ __forceinline__ void operator()(const Acc& acc, const Unit& u, int wr, int wc, int fr, int fq) const {
        const int row0 = u.pm * BM + wr * 64 + fr, col0 = u.pn * BM + wc * 32 + 8 * fq;
#pragma unroll
        for (int ai = 0; ai < 2; ++ai)
#pragma unroll
            for (int m = 0; m < 4; ++m) { const int row = row0 + ai * HALF + m * 16; const float rs = row_rstd(stats, row); bf16_t* rowp = out + (size_t)row * FF + col0;
#pragma unroll
                for (int bj = 0; bj < 2; ++bj) { f32x4 v0 = acc[ai][bj][m][0] * rs, v1 = acc[ai][bj][m][1] * rs;
#pragma unroll
                    for (int j = 0; j < 4; ++j) { v0[j] = fmaxf(v0[j], 0.f); v0[j] *= v0[j]; v1[j] = fmaxf(v1[j], 0.f); v1[j] *= v1[j]; }
                    u32x4 w; w.x = cvt_pk_bf16(v0[0], v0[1]); w.y = cvt_pk_bf16(v0[2], v0[3]); w.z = cvt_pk_bf16(v1[0], v1[1]); w.w = cvt_pk_bf16(v1[2], v1[3]);
                    *(u32x4*)(rowp + bj * HALF) = w; } }
    }
};
struct EpiStoreBf16 {
    static constexpr bool PERM = false, AFTER_DRAIN = false;
    bf16_t* t2;
    __device__ __forceinline__ void operator()(const Acc& acc, const Unit& u, int wr, int wc, int fr, int fq) const {
        const int col0 = u.pn * BM + wc * 32 + 4 * fq;
#pragma unroll
        for (int ai = 0; ai < 2; ++ai)
#pragma unroll
            for (int m = 0; m < 4; ++m) { const size_t off = (size_t)(u.pm * BM + ai * HALF + wr * 64 + m * 16 + fr) * D + col0;
#pragma unroll
                for (int bj = 0; bj < 2; ++bj)
#pragma unroll
                    for (int n = 0; n < 2; ++n) { const f32x4 v = acc[ai][bj][m][n]; u32x2 w; w.x = cvt_pk_bf16(v[0], v[1]); w.y = cvt_pk_bf16(v[2], v[3]); *(u32x2*)(t2 + off + bj * HALF + n * 16) = w; } }
    }
};
struct EpiOut {
    static constexpr bool PERM = false, AFTER_DRAIN = false;
    const float* stats; const bf16_t* t2; const bf16_t* rin; float* out;
    __device__ __forceinline__ void operator()(const Acc& acc, const Unit& u, int wr, int wc, int fr, int fq) const {
        const int col0 = u.pn * BM + wc * 32 + 4 * fq;
#pragma unroll
        for (int ai = 0; ai < 2; ++ai)
#pragma unroll
            for (int m = 0; m < 4; ++m) { const int row = u.pm * BM + ai * HALF + wr * 64 + m * 16 + fr; const size_t off = (size_t)row * D + col0; const float rs = row_rstd(stats, row);
#pragma unroll
                for (int bj = 0; bj < 2; ++bj)
#pragma unroll
                    for (int n = 0; n < 2; ++n) { const u32x2 rw = *(const u32x2*)(rin + off + bj * HALF + n * 16), tw = *(const u32x2*)(t2 + off + bj * HALF + n * 16); const f32x4 r = (f32x4){bf_lo(rw.x), bf_hi(rw.x), bf_lo(rw.y), bf_hi(rw.y)}, t = (f32x4){bf_lo(tw.x), bf_hi(tw.x), bf_lo(tw.y), bf_hi(tw.y)}; f32x4 v = acc[ai][bj][m][n] * rs;
#pragma unroll
                        for (int j = 0; j < 4; ++j) v[j] = r[j] + sigmoidf_fast(v[j]) * t[j];
                        *(f32x4*)(out + off + bj * HALF + n * 16) = v; }
                if (m & 1) asm volatile("" ::: "memory"); }
    }
};

#define PG8_LAS LAS
template <class Epi, class Sched, bool ALIGN_EPI = false, bool SP2 = false>
__device__ __forceinline__ void gemm_phase(PG8_LAS unsigned char* lds, const Gemm g, const Sched& S, const Epi& E, const int wv) {
    const int tid_ = wv * 64 + lane_id_asm();
    const int tid = tid_, wid = wv, lane = tid & 63, wr = wid >> 2, wc = wid & 3, fr = lane & 15, fq = lane >> 4;
    const int K = g.K, nt = K / BK;
    unsigned voffA[2], voffB[2];
#pragma unroll
    for (int i = 0; i < 2; ++i) { int R, C; stage_rc(tid * 16 + i * 8192, R, C); const int Rb = Epi::PERM ? ((R & ~31) + perm32(R & 31)) : R;
        voffA[i] = (unsigned)(R * K + C) * 2u; voffB[i] = (unsigned)(Rb * K + C) * 2u; }
    const size_t kstep = (size_t)(BK * 2);
    const size_t hstep = (size_t)HALF * K * 2;
    const size_t tstep = 2 * hstep;
    const unsigned ldsw = (unsigned)wid * 1024u;
    const int aoff = lds_byte(wr * 64 + fr, fq * 8), boff = lds_byte(wc * 32 + fr, fq * 8);
#define PG8_SA(b, h) (((b) * 2 + (h)) * HTB)
#define PG8_SB(b, h) ((4 + (b) * 2 + (h)) * HTB)
#define PG8_STAGE(bufoff, gbase, voff) do { _Pragma("unroll") for (int _i = 0; _i < 2; ++_i) \
        __builtin_amdgcn_global_load_lds((const unsigned*)((const char*)(gbase) + (voff)[_i]), (PG8_LAS unsigned*)(lds + (bufoff) + ldsw + _i * 8192), 16, 0, 0); } while (0)
#define PG8_LDA(dst, b, h) do { _Pragma("unroll") for (int m = 0; m < 4; ++m) _Pragma("unroll") for (int k = 0; k < 2; ++k) dst[m][k] = *(const PG8_LAS bf16x8*)(lds + PG8_SA(b, h) + aoff + m * 2048 + k * 1024); } while (0)
#define PG8_LDB(dst, b, h) do { _Pragma("unroll") for (int n = 0; n < 2; ++n) _Pragma("unroll") for (int k = 0; k < 2; ++k) dst[n][k] = *(const PG8_LAS bf16x8*)(lds + PG8_SB(b, h) + boff + n * 2048 + k * 1024); } while (0)
#define PG8_MMA(ai, bj, At, Bt) do { __builtin_amdgcn_s_setprio(1); _Pragma("unroll") for (int m = 0; m < 4; ++m) _Pragma("unroll") for (int n = 0; n < 2; ++n) _Pragma("unroll") for (int k = 0; k < 2; ++k) \
        acc[ai][bj][m][n] = __builtin_amdgcn_mfma_f32_16x16x32_bf16(Bt[n][k], At[m][k], acc[ai][bj][m][n], 0, 0, 0); __builtin_amdgcn_s_setprio(0); } while (0)
#define PG8_WAIT_V(n) asm volatile("s_waitcnt vmcnt(" #n ")" ::: "memory")
#define PG8_WAIT_L(n) asm volatile("s_waitcnt lgkmcnt(" #n ")" ::: "memory")
#define PG8_BAR __builtin_amdgcn_s_barrier()
#define PG8_SCHED __builtin_amdgcn_sched_barrier(0)
    Unit cur, nxt; int ui = 0;
    if (!S.next(0, cur)) return;
    f32x4 acc[2][2][4][2];
#pragma unroll
    for (int a = 0; a < 2; ++a)
#pragma unroll
        for (int b = 0; b < 2; ++b)
#pragma unroll
            for (int m = 0; m < 4; ++m)
#pragma unroll
                for (int n = 0; n < 2; ++n) acc[a][b][m][n] = (f32x4){0.f, 0.f, 0.f, 0.f};
    bf16x8 At[4][2], B0[2][2], B1[2][2];
    const char* cA = (const char*)g.A + (size_t)cur.pm * tstep; const char* cB = (const char*)g.Bt + (size_t)cur.pn * tstep;
    S.a_ready(cur);
    if constexpr (SP2) {
        PG8_STAGE(PG8_SB(0, 0), cB, voffB); PG8_STAGE(PG8_SB(0, 1), cB + hstep, voffB); PG8_STAGE(PG8_SA(0, 0), cA, voffA); PG8_STAGE(PG8_SA(0, 1), cA + hstep, voffA);
        if (wr == 1) PG8_BAR;
        PG8_WAIT_V(2); PG8_BAR;
        PG8_STAGE(PG8_SB(1, 0), cB + kstep, voffB); PG8_STAGE(PG8_SA(1, 0), cA + kstep, voffA); PG8_STAGE(PG8_SB(1, 1), cB + hstep + kstep, voffB);
        PG8_WAIT_V(6); PG8_BAR;
    } else {
        PG8_STAGE(PG8_SB(0, 0), cB, voffB); PG8_STAGE(PG8_SA(0, 0), cA, voffA); PG8_STAGE(PG8_SB(0, 1), cB + hstep, voffB); PG8_STAGE(PG8_SA(0, 1), cA + hstep, voffA);
        if (wr == 1) PG8_BAR;
        PG8_WAIT_V(4); PG8_BAR;
        PG8_STAGE(PG8_SB(1, 0), cB + kstep, voffB); PG8_STAGE(PG8_SA(1, 0), cA + kstep, voffA); PG8_STAGE(PG8_SB(1, 1), cB + hstep + kstep, voffB);
        PG8_WAIT_V(6); PG8_BAR;
    }
    for (;;) {
        const bool has_next = S.next(ui + 1, nxt);
        const char* nA = has_next ? (const char*)g.A + (size_t)nxt.pm * tstep : cA; const char* nB = has_next ? (const char*)g.Bt + (size_t)nxt.pn * tstep : cB;
        for (int t = 0; t < nt; t += 2) {
            const bool last = (t == nt - 2);
            const char* a1 = cA + (size_t)(t + 1) * kstep;
            const char* a2 = last ? nA : cA + (size_t)(t + 2) * kstep; const char* b2 = last ? nB : cB + (size_t)(t + 2) * kstep;
            const char* a3 = a2 + kstep; const char* b3 = b2 + kstep;
            if (last && has_next) S.a_ready(nxt);
            if constexpr (SP2) {
            PG8_LDB(B0, 0, 0); PG8_LDB(B1, 0, 1); PG8_SCHED; PG8_LDA(At, 0, 0); PG8_STAGE(PG8_SA(1, 1), a1 + hstep, voffA);
            PG8_WAIT_V(8); PG8_WAIT_L(0); PG8_BAR; PG8_MMA(0, 0, At, B0); PG8_MMA(0, 1, At, B1); PG8_BAR; PG8_SCHED;
            PG8_LDA(At, 0, 1); PG8_STAGE(PG8_SB(0, 0), b2, voffB); PG8_STAGE(PG8_SB(0, 1), b2 + hstep, voffB); PG8_STAGE(PG8_SA(0, 0), a2, voffA);
            PG8_WAIT_V(8); PG8_WAIT_L(0); PG8_BAR; PG8_MMA(1, 0, At, B0); PG8_MMA(1, 1, At, B1); PG8_BAR; PG8_SCHED;
            PG8_LDB(B0, 1, 0); PG8_LDB(B1, 1, 1); PG8_SCHED; PG8_LDA(At, 1, 0); PG8_STAGE(PG8_SA(0, 1), a2 + hstep, voffA);
            PG8_WAIT_V(8); PG8_WAIT_L(0); PG8_BAR; PG8_MMA(0, 0, At, B0); PG8_MMA(0, 1, At, B1); PG8_BAR; PG8_SCHED;
            PG8_LDA(At, 1, 1); PG8_STAGE(PG8_SB(1, 0), b3, voffB); PG8_STAGE(PG8_SB(1, 1), b3 + hstep, voffB); PG8_STAGE(PG8_SA(1, 0), a3, voffA);
            PG8_WAIT_V(8); PG8_WAIT_L(0); PG8_BAR; PG8_MMA(1, 0, At, B0); PG8_MMA(1, 1, At, B1); PG8_BAR; PG8_SCHED;
            } else {
            PG8_LDB(B0, 0, 0); PG8_SCHED; PG8_LDA(At, 0, 0); PG8_STAGE(PG8_SA(1, 1), a1 + hstep, voffA);
            PG8_WAIT_L(8); PG8_BAR; PG8_WAIT_L(0); PG8_MMA(0, 0, At, B0); PG8_BAR; PG8_SCHED;
            PG8_LDB(B1, 0, 1); PG8_STAGE(PG8_SB(0, 0), b2, voffB);
            PG8_BAR; PG8_WAIT_L(0); PG8_MMA(0, 1, At, B1); PG8_BAR;
            PG8_LDA(At, 0, 1); PG8_STAGE(PG8_SA(0, 0), a2, voffA);
            PG8_BAR; PG8_WAIT_L(0); PG8_MMA(1, 0, At, B0); PG8_BAR; PG8_SCHED;
            PG8_STAGE(PG8_SB(0, 1), b2 + hstep, voffB);
            PG8_WAIT_V(6); PG8_BAR; PG8_MMA(1, 1, At, B1); PG8_BAR;
            PG8_LDB(B0, 1, 0); PG8_SCHED; PG8_LDA(At, 1, 0); PG8_STAGE(PG8_SA(0, 1), a2 + hstep, voffA);
            PG8_WAIT_L(8); PG8_BAR; PG8_WAIT_L(0); PG8_MMA(0, 0, At, B0); PG8_BAR; PG8_SCHED;
            PG8_LDB(B1, 1, 1); PG8_STAGE(PG8_SB(1, 0), b3, voffB);
            PG8_BAR; PG8_WAIT_L(0); PG8_MMA(0, 1, At, B1); PG8_BAR;
            PG8_LDA(At, 1, 1); PG8_STAGE(PG8_SA(1, 0), a3, voffA);
            PG8_BAR; PG8_WAIT_L(0); PG8_MMA(1, 0, At, B0); PG8_BAR; PG8_SCHED;
            PG8_STAGE(PG8_SB(1, 1), b3 + hstep, voffB);
            PG8_WAIT_V(6); PG8_BAR; PG8_MMA(1, 1, At, B1); PG8_BAR;
            }
        }
        if constexpr (ALIGN_EPI) { if (wr == 0) PG8_BAR; }
        if constexpr (!Epi::AFTER_DRAIN) { E(acc, cur, wr, wc, fr, fq); S.done(cur); }
        if (!has_next) break;
#pragma unroll
        for (int a = 0; a < 2; ++a)
#pragma unroll
            for (int b = 0; b < 2; ++b)
#pragma unroll
                for (int m = 0; m < 4; ++m)
#pragma unroll
                    for (int n = 0; n < 2; ++n) acc[a][b][m][n] = (f32x4){0.f, 0.f, 0.f, 0.f};
        cur = nxt; cA = nA; cB = nB; ++ui;
        if constexpr (ALIGN_EPI) { if (wr == 1) PG8_BAR; }
    }
    PG8_WAIT_V(0);
    if constexpr (!ALIGN_EPI) { if (wr == 0) PG8_BAR; }
    PG8_BAR;
    if constexpr (Epi::AFTER_DRAIN) { E.fused(acc, cur, wr, wc, fr, fq, lds, wid, lane); S.done(cur); }
#undef PG8_SA
#undef PG8_SB
#undef PG8_STAGE
#undef PG8_LDA
#undef PG8_LDB
#undef PG8_MMA
#undef PG8_WAIT_V
#undef PG8_WAIT_L
#undef PG8_BAR
#undef PG8_SCHED
}
}

constexpr int RING_BYTES = 131072;

__device__ __forceinline__ float wave_sum(float v) {
#pragma unroll
    for (int o = 1; o < 64; o <<= 1) v += __shfl_xor(v, o);
    return v;
}
__device__ __forceinline__ float wave_max(float v) {
#pragma unroll
    for (int o = 1; o < 64; o <<= 1) v = fmaxf(v, __shfl_xor(v, o));
    return v;
}

struct TrDesc { const float* W; const float* g; bf16_t* WT; int K, N, k0, n0; };
template <int KT> struct TrTile {
    static constexpr int RPW = KT / 8, KCW = KT / 64;
    static __device__ __forceinline__ void load(const TrDesc& d, int wave, int lane, f32x4 (&v)[RPW]) {
        const float* src = d.W + (size_t)(d.k0 + wave * RPW) * d.N + d.n0 + lane * 4;
#pragma unroll
        for (int i = 0; i < RPW; ++i) v[i] = __builtin_nontemporal_load((const f32x4*)(src + (size_t)i * d.N));
    }
    static __device__ __forceinline__ void to_lds(const TrDesc& d, LAS float* scr, int wave, int lane, f32x4 (&v)[RPW]) {
#pragma unroll
        for (int i = 0; i < RPW; ++i) { f32x4 x = v[i]; if (d.g) x = x * d.g[d.k0 + wave * RPW + i]; *(LAS f32x4*)(scr + (wave * RPW + i) * 256 + lane * 4) = x; }
    }
    static __device__ __forceinline__ void store(const TrDesc& d, const LAS float* scr, int wave, int lane) {
#pragma unroll
        for (int c = 0; c < KCW; ++c) { const int kc = wave * KCW + c;
#pragma unroll
            for (int q = 0; q < 4; ++q) { const int n = lane + 64 * q; const LAS float* t = scr + (8 * kc) * 256 + n;
                u32x4 o; o.x = cvt_pk_bf16(t[0 * 256], t[1 * 256]); o.y = cvt_pk_bf16(t[2 * 256], t[3 * 256]); o.z = cvt_pk_bf16(t[4 * 256], t[5 * 256]); o.w = cvt_pk_bf16(t[6 * 256], t[7 * 256]);
                *(u32x4*)(d.WT + (size_t)(d.n0 + n) * d.K + d.k0 + 8 * kc) = o; } }
    }
};

struct Ptrs {
    const float *x, *p, *g_mix, *w_in, *g_q, *g_k, *w_conv, *w_ao, *w_co, *w_o, *g_mlp, *w_up, *w_dn, *g_ple, *w_g, *w_pp;
    float* out; unsigned char* ws;
};

constexpr int LT_AO = (AW / 128) * (D / 256), LT_CO = (CW / 128) * (D / 256), LT_O = (D / 128) * (D / 256), LT_UP = (D / 128) * (FF / 256), LT_DN = (FF / 128) * (D / 256), LT_G = LT_O, LT_PP = (PLE / 128) * (D / 256);
constexpr int N_LATE_ITEMS = LT_AO + LT_CO + LT_O + LT_UP + LT_DN + LT_G + LT_PP;
__device__ __forceinline__ TrDesc late_desc(const Ptrs& P, int it) {
    unsigned char* ws = P.ws; int r = it; TrDesc d;
    if (r < LT_AO) { d.W = P.w_ao; d.g = nullptr; d.WT = (bf16_t*)(ws + WS_WAO); d.K = AW; d.N = D; }
    else if ((r -= LT_AO) < LT_CO) { d.W = P.w_co; d.g = nullptr; d.WT = (bf16_t*)(ws + WS_WCO); d.K = CW; d.N = D; }
    else if ((r -= LT_CO) < LT_O) { d.W = P.w_o; d.g = nullptr; d.WT = (bf16_t*)(ws + WS_WO); d.K = D; d.N = D; }
    else if ((r -= LT_O) < LT_UP) { d.W = P.w_up; d.g = P.g_mlp; d.WT = (bf16_t*)(ws + WS_WUP); d.K = D; d.N = FF; }
    else if ((r -= LT_UP) < LT_DN) { d.W = P.w_dn; d.g = nullptr; d.WT = (bf16_t*)(ws + WS_WDN); d.K = FF; d.N = D; }
    else if ((r -= LT_DN) < LT_G) { d.W = P.w_g; d.g = P.g_ple; d.WT = (bf16_t*)(ws + WS_WG); d.K = D; d.N = D; }
    else { r -= LT_G; d.W = P.w_pp; d.g = nullptr; d.WT = (bf16_t*)(ws + WS_WPP); d.K = PLE; d.N = D; }
    const int nblk = d.N >> 8, kb = r / nblk, nb = r - kb * nblk; d.k0 = kb * 128; d.n0 = nb << 8;
    return d;
}
__device__ __forceinline__ void late_weight_steal(const Ptrs& P, LAS unsigned char* lds, unsigned* ctr, int wave, int lane) {
    LAS float* scr = (LAS float*)lds;
    volatile LAS unsigned* slot = (volatile LAS unsigned*)(lds + LDS_BYTES - 32);
    const bool t0 = (wave == 0 && lane == 0);
    if (t0) slot[0] = __hip_atomic_fetch_add(ctr, 1u, __ATOMIC_RELAXED, __HIP_MEMORY_SCOPE_AGENT);
    __syncthreads();
    unsigned it = __builtin_amdgcn_readfirstlane(slot[0]);
    if (it >= (unsigned)N_LATE_ITEMS) return;
    TrDesc d = late_desc(P, (int)it);
    f32x4 v[16];
    TrTile<128>::load(d, wave, lane, v);
    for (;;) {
        __syncthreads();
        TrTile<128>::to_lds(d, scr, wave, lane, v);
        if (t0) slot[0] = __hip_atomic_fetch_add(ctr, 1u, __ATOMIC_RELAXED, __HIP_MEMORY_SCOPE_AGENT);
        __syncthreads();
        const unsigned nxt = __builtin_amdgcn_readfirstlane(slot[0]);
        const bool more = nxt < (unsigned)N_LATE_ITEMS;
        TrDesc dn = d;
        if (more) { dn = late_desc(P, (int)nxt); TrTile<128>::load(dn, wave, lane, v); }
        TrTile<128>::store(d, scr, wave, lane);
        if (!more) break;
        d = dn;
    }
    __syncthreads();
}

__device__ __forceinline__ void p0_prologue(const Ptrs& P, LAS unsigned char* lds, int vcu, int G, int wave, int lane) {
    const int gw = vcu * NWAVES + wave, NGW = G * NWAVES;
    unsigned char* ws = P.ws;
    {
        constexpr int I0 = (D / 64) * (NZ / 256), NBLK_N = NZ / 256;
        LAS float* scr = (LAS float*)lds;
        int it = vcu;
        if (it < I0) {
            TrDesc d; d.W = P.w_in; d.g = P.g_mix; d.WT = (bf16_t*)(ws + WS_WIN); d.K = D; d.N = NZ; d.k0 = (it / NBLK_N) * 64; d.n0 = (it % NBLK_N) << 8;
            f32x4 v[8];
            TrTile<64>::load(d, wave, lane, v);
            for (;;) {
                __syncthreads();
                TrTile<64>::to_lds(d, scr, wave, lane, v);
                __syncthreads();
                const int nxt = it + G; const bool more = nxt < I0;
                TrDesc dn = d;
                if (more) { dn.k0 = (nxt / NBLK_N) * 64; dn.n0 = (nxt % NBLK_N) << 8; TrTile<64>::load(dn, wave, lane, v); }
                TrTile<64>::store(d, scr, wave, lane);
                if (!more) break;
                d = dn; it = nxt;
            }
        }
    }
    bf16_t* hb = (bf16_t*)(ws + WS_HB);
    for (int m = gw; m < M; m += NGW) {
        const f32x4* xr = (const f32x4*)(P.x + (size_t)m * D) + lane;
        f32x4 v[8]; float s = 0.f;
#pragma unroll
        for (int j = 0; j < 8; ++j) { v[j] = xr[64 * j]; s += (v[j][0] * v[j][0] + v[j][1] * v[j][1]) + (v[j][2] * v[j][2] + v[j][3] * v[j][3]); }
        const float rs = __builtin_amdgcn_rsqf(wave_sum(s) * (1.0f / D) + RMS_EPS);
        u32x2* o = (u32x2*)(hb + (size_t)m * D) + lane;
#pragma unroll
        for (int j = 0; j < 8; ++j) { u32x2 w; w.x = cvt_pk_bf16(v[j][0] * rs, v[j][1] * rs); w.y = cvt_pk_bf16(v[j][2] * rs, v[j][3] * rs); o[64 * j] = w; }
    }
    bf16_t* pb = (bf16_t*)(ws + WS_PB);
    for (int i = gw * 64 + lane; i < M * PLE / 8; i += NGW * 64) {
        const f32x4 a = *(const f32x4*)(P.p + (size_t)i * 8), b = *(const f32x4*)(P.p + (size_t)i * 8 + 4);
        u32x4 w; w.x = cvt_pk_bf16(a[0], a[1]); w.y = cvt_pk_bf16(a[2], a[3]); w.z = cvt_pk_bf16(b[0], b[1]); w.w = cvt_pk_bf16(b[2], b[3]);
        *(u32x4*)(pb + (size_t)i * 8) = w;
    }
}

constexpr int P2_VPITCH = 272;
constexpr int P2_RED_OFF = 256 * P2_VPITCH;
__device__ __forceinline__ void unpack8(const u32x4 w, float (&f)[8]) {
    f[0] = bf_lo(w.x); f[1] = bf_hi(w.x); f[2] = bf_lo(w.y); f[3] = bf_hi(w.y); f[4] = bf_lo(w.z); f[5] = bf_hi(w.z); f[6] = bf_lo(w.w); f[7] = bf_hi(w.w);
}
__device__ __forceinline__ u32x4 pack8(const float (&f)[8]) { u32x4 w; w.x = cvt_pk_bf16(f[0], f[1]); w.y = cvt_pk_bf16(f[2], f[3]); w.z = cvt_pk_bf16(f[4], f[5]); w.w = cvt_pk_bf16(f[6], f[7]); return w; }
__device__ __forceinline__ float sum16(float s) { s += __shfl_xor(s, 1); s += __shfl_xor(s, 2); s += __shfl_xor(s, 4); s += __shfl_xor(s, 8); return s; }

__device__ __forceinline__ void p2_unit(const Ptrs& P, LAS unsigned char* lds, int item, int tid, bf16_t* qdst, bf16_t* kdst, bf16_t* cbdst) {
    unsigned char* ws = P.ws;
    const int b = item >> 7, n = (item >> 3) & 15, h = item & 7;
    const int cch = tid & 15, rg = tid >> 4, lane = tid & 63, wave = tid >> 6;
    const int c0 = h * 128 + cch * 8;
    bf16_t* qb = (bf16_t*)(ws + WS_Q); bf16_t* kb = (bf16_t*)(ws + WS_K); const bf16_t* vb = (const bf16_t*)(ws + WS_V);
    bf16_t* cb = (bf16_t*)(ws + WS_CB); const bf16_t* cc = (const bf16_t*)(ws + WS_CC); const bf16_t* cx = (const bf16_t*)(ws + WS_CX);
    float gq[8], gk[8], w0[8], w1[8], w2[8], ksum[8];
#pragma unroll
    for (int j = 0; j < 8; ++j) { gq[j] = P.g_q[cch * 8 + j] * QSCALE; gk[j] = P.g_k[cch * 8 + j]; w0[j] = P.w_conv[c0 + j]; w1[j] = P.w_conv[CW + c0 + j]; w2[j] = P.w_conv[2 * CW + c0 + j]; ksum[j] = 0.f; }
#pragma unroll 1
    for (int i = 0; i < 8; ++i) {
        const int rl = rg + 32 * i, t = n * 256 + rl; const size_t off = (size_t)(b * SEQ + t) * 1024 + c0;
        float f[8];
        {
            unpack8(*(const u32x4*)(qb + off), f); float s = 0.f;
#pragma unroll
            for (int j = 0; j < 8; ++j) s += f[j] * f[j];
            const float rs = __builtin_amdgcn_rsqf(sum16(s) * (1.0f / HD) + RMS_EPS);
#pragma unroll
            for (int j = 0; j < 8; ++j) f[j] = f[j] * rs * gq[j];
            *(u32x4*)(qdst + off) = pack8(f);
        }
        {
            unpack8(*(const u32x4*)(kb + off), f); float s = 0.f;
#pragma unroll
            for (int j = 0; j < 8; ++j) s += f[j] * f[j];
            const float rs = __builtin_amdgcn_rsqf(sum16(s) * (1.0f / HD) + RMS_EPS);
#pragma unroll
            for (int j = 0; j < 8; ++j) { f[j] = f[j] * rs * gk[j]; ksum[j] += f[j]; }
            *(u32x4*)(kdst + off) = pack8(f);
        }
        *(LAS u32x4*)(lds + rl * P2_VPITCH + cch * 16) = *(const u32x4*)(vb + off);
        {
            float a[8], c[8], y[8];
            unpack8(*(const u32x4*)(cc + off), a); unpack8(*(const u32x4*)(cx + off), c);
#pragma unroll
            for (int j = 0; j < 8; ++j) y[j] = w2[j] * (a[j] * c[j]);
            if (t >= 1) { unpack8(*(const u32x4*)(cc + off - 1024), a); unpack8(*(const u32x4*)(cx + off - 1024), c);
#pragma unroll
                for (int j = 0; j < 8; ++j) y[j] += w1[j] * (a[j] * c[j]); }
            if (t >= 2) { unpack8(*(const u32x4*)(cc + off - 2048), a); unpack8(*(const u32x4*)(cx + off - 2048), c);
#pragma unroll
                for (int j = 0; j < 8; ++j) y[j] += w0[j] * (a[j] * c[j]); }
            unpack8(*(const u32x4*)(cb + off), a);
#pragma unroll
            for (int j = 0; j < 8; ++j) y[j] *= a[j];
            *(u32x4*)(cbdst + off) = pack8(y);
        }
    }
    LAS float* red = (LAS float*)(lds + P2_RED_OFF);
#pragma unroll
    for (int j = 0; j < 8; ++j) { float s = ksum[j]; s += __shfl_xor(s, 16); s += __shfl_xor(s, 32); if (lane < 16) red[wave * 128 + cch * 8 + j] = s; }
    __syncthreads();
    if (tid < 128) { float s = 0.f;
#pragma unroll
        for (int w = 0; w < 8; ++w) s += red[w * 128 + tid];
        ((float*)(ws + WS_KMEAN))[((size_t)((b * NH + h) * NBLK + n)) * 128 + tid] = s * (1.0f / MOBA_BLK); }
    bf16_t* vt = (bf16_t*)(ws + WS_VT) + (size_t)((b * NH + h) * 64 + n * 4) * (128 * 64);
#pragma unroll 2
    for (int i = 0; i < 8; ++i) {
        const int ch = tid + 512 * i, d = ch & 127, kc = ch >> 7;
        const int kbase = (kc >> 1) * 16 + 4 * (kc & 1);
        unsigned short e[8];
#pragma unroll
        for (int j = 0; j < 8; ++j) e[j] = *(const LAS unsigned short*)(lds + (kbase + 8 * (j >> 2) + (j & 3)) * P2_VPITCH + d * 2);
        u32x4 w; w.x = e[0] | ((unsigned)e[1] << 16); w.y = e[2] | ((unsigned)e[3] << 16); w.z = e[4] | ((unsigned)e[5] << 16); w.w = e[6] | ((unsigned)e[7] << 16);
        const int kt = kc >> 3, slot0 = (kc & 7) * 8;
        *(u32x4*)(vt + (size_t)(kt * 128 + d) * 64 + slot0) = w;
    }
    __syncthreads();
}

constexpr int AT_KBUF = 128 * 256, AT_VBUF = 2 * 128 * 128;
constexpr int AT_STAGE = AT_KBUF + AT_VBUF;
#define MFMA32(a, b, c) __builtin_amdgcn_mfma_f32_32x32x16_bf16((a), (b), (c), 0, 0, 0)

__device__ __forceinline__ void attn_unit(const Ptrs& P, LAS unsigned char* lds, int bh, int qb, int half, int tid, bf16_t* Obuf) {
    unsigned char* ws = P.ws;
    const int b = bh >> 3, h = bh & 7;
    const int lane = tid & 63, r32 = lane & 31, hi = lane >> 5, wid = __builtin_amdgcn_readfirstlane(tid >> 6), wq = wid & 3, wk = wid >> 2;
    const bf16_t* Qn = (const bf16_t*)(ws + WS_Q); const bf16_t* Kn = (const bf16_t*)(ws + WS_K);
    const bf16_t* Vt = (const bf16_t*)(ws + WS_VT) + (size_t)bh * 64 * (128 * 64);
    const float* Kmean = (const float*)(ws + WS_KMEAN) + (size_t)bh * NBLK * 128;
    const size_t rowbase = (size_t)b * SEQ;
    const int qi = half * 128 + wq * 32 + r32;
    const size_t qrow = rowbase + qb * 256 + qi;

    const char* ksrc[4]; const char* vsrc[4];
#pragma unroll
    for (int i_ = 0; i_ < 4; ++i_) {
        const int pk = wid + 8 * i_, key = pk * 4 + (lane >> 4), ck = (lane & 15) ^ (key & 15);
        ksrc[i_] = (const char*)(Kn + (rowbase + key) * 1024 + h * 128 + ck * 8);
        const int pv = wid + 8 * i_, rr = pv * 8 + (lane >> 3), cv = (lane & 7) ^ ((rr >> 1) & 7);
        vsrc[i_] = (const char*)(Vt + (size_t)rr * 64 + cv * 8);
    }
#define AT_LOAD(it, buf) do { _Pragma("unroll") for (int i_ = 0; i_ < 4; ++i_) { \
        __builtin_amdgcn_global_load_lds((const unsigned*)(ksrc[i_] + (size_t)(it) * (128 * 1024 * 2)), (LAS unsigned*)(lds + (buf) * AT_STAGE + (wid + 8 * i_) * 1024), 16, 0, 0); \
        __builtin_amdgcn_global_load_lds((const unsigned*)(vsrc[i_] + (size_t)(it) * (2 * 128 * 64 * 2)), (LAS unsigned*)(lds + (buf) * AT_STAGE + AT_KBUF + (wid + 8 * i_) * 1024), 16, 0, 0); } } while (0)
#define AT_PUBLISH() do { asm volatile("s_waitcnt vmcnt(0)" ::: "memory"); __syncthreads(); } while (0)
    AT_LOAD(0, 0);

    bf16x8 qf[8];
#pragma unroll
    for (int d0 = 0; d0 < 8; ++d0) qf[d0] = *(const bf16x8*)(Qn + qrow * 1024 + h * 128 + d0 * 16 + hi * 8);

    float mref;
    { const float a = fabsf(P.g_q[lane] * P.g_k[lane]), c = fabsf(P.g_q[lane + 64] * P.g_k[lane + 64]); mref = wave_max(fmaxf(a, c)) * (11.313708498984761f * LOG2E); }

    unsigned selmask = 0u;
    {
        f32x16 g;
#pragma unroll
        for (int r = 0; r < 16; ++r) g[r] = 0.f;
#pragma unroll
        for (int d0 = 0; d0 < 8; ++d0) {
            u32x4 a = (u32x4){0u, 0u, 0u, 0u};
            if (r32 < 16) { const f32x4 x0 = *(const f32x4*)(Kmean + r32 * 128 + d0 * 16 + hi * 8), x1 = *(const f32x4*)(Kmean + r32 * 128 + d0 * 16 + hi * 8 + 4);
                a.x = cvt_pk_bf16(x0[0], x0[1]); a.y = cvt_pk_bf16(x0[2], x0[3]); a.z = cvt_pk_bf16(x1[0], x1[1]); a.w = cvt_pk_bf16(x1[2], x1[3]); }
            g = MFMA32(__builtin_bit_cast(bf16x8, a), qf[d0], g);
        }
        float gate[16];
#pragma unroll
        for (int r = 0; r < 8; ++r) { const float mine = g[r], other = __shfl_xor(mine, 32); const int bl = (r & 3) + 8 * (r >> 2);
            gate[bl] = hi == 0 ? mine : other; gate[bl + 4] = hi == 0 ? other : mine; }
#pragma unroll
        for (int pass = 0; pass < TOPK; ++pass) { float best = -INFINITY; int bi = -1;
#pragma unroll
            for (int nb = 0; nb < 16; ++nb) { const bool ok = (nb < qb) && !((selmask >> nb) & 1u) && (gate[nb] > best); best = ok ? gate[nb] : best; bi = ok ? nb : bi; }
            if (bi >= 0) selmask |= 1u << bi; }
    }

    f32x16 o[4];
#pragma unroll
    for (int dt = 0; dt < 4; ++dt)
#pragma unroll
        for (int r = 0; r < 16; ++r) o[dt][r] = 0.f;
    float lsum = 0.f;

    AT_PUBLISH();
    const int NIT = 2 * qb + 1 + half;
#pragma unroll 1
    for (int it = 0; it < NIT; ++it) {
        const int cur = it & 1, n = it >> 1, kt = 2 * (it & 1) + wk;
        if (it + 1 < NIT) AT_LOAD(it + 1, cur ^ 1);
        const bool diag = (n == qb);
        const bool lane_on = diag || ((selmask >> n) & 1u);
        const LAS unsigned char* kbuf = lds + cur * AT_STAGE + (wk * 64 + r32) * 256 + ((hi ^ (r32 & 1)) << 4);
        const LAS unsigned char* vbuf = lds + cur * AT_STAGE + AT_KBUF + (wk * 128 + r32) * 128 + ((hi ^ ((r32 >> 1) & 1)) << 4);
        const int kxs = (r32 >> 1) & 7, vxs = (r32 >> 2) & 3;
        if (diag || __any(lane_on)) {
#pragma unroll
            for (int kh = 0; kh < 2; ++kh) {
                if (diag && (2 * kt + kh > half * 4 + wq)) continue;
                f32x16 s;
#pragma unroll
                for (int r = 0; r < 16; ++r) s[r] = 0.f;
#pragma unroll
                for (int d0 = 0; d0 < 8; ++d0) { const bf16x8 a = *(const LAS bf16x8*)(kbuf + kh * 32 * 256 + ((d0 ^ kxs) << 5)); s = MFMA32(a, qf[d0], s); }
                const int kbase = 64 * kt + 32 * kh + 4 * hi;
#pragma unroll
                for (int r = 0; r < 16; ++r) { const int kidx = kbase + (r & 3) + 8 * (r >> 2); const bool valid = diag ? (kidx <= qi) : lane_on;
                    const float p = __builtin_amdgcn_exp2f(s[r] - mref); s[r] = valid ? p : 0.f; lsum += s[r]; }
#pragma unroll
                for (int sg = 0; sg < 2; ++sg) {
                    u32x4 pw; pw.x = cvt_pk_bf16(s[8 * sg + 0], s[8 * sg + 1]); pw.y = cvt_pk_bf16(s[8 * sg + 2], s[8 * sg + 3]); pw.z = cvt_pk_bf16(s[8 * sg + 4], s[8 * sg + 5]); pw.w = cvt_pk_bf16(s[8 * sg + 6], s[8 * sg + 7]);
                    const bf16x8 pf = __builtin_bit_cast(bf16x8, pw);
#pragma unroll
                    for (int dt = 0; dt < 4; ++dt) { const bf16x8 a = *(const LAS bf16x8*)(vbuf + dt * 32 * 128 + (((kh * 2 + sg) ^ vxs) << 5)); o[dt] = MFMA32(a, pf, o[dt]); }
                }
            }
        }
        AT_PUBLISH();
    }
    lsum += __shfl_xor(lsum, 32);
    LAS float* xch = (LAS float*)lds + (size_t)(wq * 64 + lane) * 65;
    if (wk == 1) {
#pragma unroll
        for (int dt = 0; dt < 4; ++dt)
#pragma unroll
            for (int r = 0; r < 16; ++r) xch[dt * 16 + r] = o[dt][r];
        xch[64] = lsum;
    }
    __syncthreads();
    if (wk == 0) {
#pragma unroll
        for (int dt = 0; dt < 4; ++dt)
#pragma unroll
            for (int r = 0; r < 16; ++r) o[dt][r] += xch[dt * 16 + r];
        lsum += xch[64];
        const float rl = __builtin_amdgcn_rcpf(lsum);
        bf16_t* orow = Obuf + qrow * 1024 + h * 128;
#pragma unroll
        for (int dt = 0; dt < 4; ++dt)
#pragma unroll
            for (int gq = 0; gq < 4; ++gq) { u32x2 w; w.x = cvt_pk_bf16(o[dt][4 * gq] * rl, o[dt][4 * gq + 1] * rl); w.y = cvt_pk_bf16(o[dt][4 * gq + 2] * rl, o[dt][4 * gq + 3] * rl);
                *(u32x2*)(orow + dt * 32 + 8 * gq + 4 * hi) = w; }
    }
    __syncthreads();
#undef AT_LOAD
#undef AT_PUBLISH
}


#define XB_TMO      128
#define XB_XCNT(j)  (256  + 64 * (j))
#define XB_XSUB(j)  (1280 + 64 * (j))
#define XB_XGEN(j)  (2304 + 64 * (j))
#define XB_TOP      3328
#define XB_TOPGEN   3392
#define XCD_BAR_WORDS 3456
#define XB_SPIN_CAP (1u << 18)
__device__ __forceinline__ unsigned xb_ld(unsigned* p)              { return __hip_atomic_load(p, __ATOMIC_RELAXED, __HIP_MEMORY_SCOPE_AGENT); }
__device__ __forceinline__ unsigned xb_add(unsigned* p, unsigned v) { return __hip_atomic_fetch_add(p, v, __ATOMIC_RELAXED, __HIP_MEMORY_SCOPE_AGENT); }
__device__ __forceinline__ unsigned xb_xcc_id() { return (unsigned)__builtin_amdgcn_s_getreg((3 << 11) | 20) & 0xFu; }
#define XB_SPIN(cond, bar) do { unsigned _sp = 0; while (cond) { __builtin_amdgcn_s_sleep(1); \
    if ((++_sp & 255u) == 0u) { if (xb_ld(&(bar)[XB_TMO])) break; if (_sp > XB_SPIN_CAP) { atomicAdd(&(bar)[XB_TMO], 1u); break; } } } } while (0)
struct XcdBarrier { unsigned* bar; unsigned x; volatile LAS unsigned* st; };
__device__ __forceinline__ XcdBarrier xcd_barrier_post(unsigned* bar, volatile LAS unsigned* st, int tid) {
    XcdBarrier b; b.bar = bar; b.x = xb_xcc_id(); b.st = st;
    if (tid == 0) (void)xb_add(&bar[XB_XCNT(b.x)], 1u);
    return b;
}
__device__ __forceinline__ void xcd_barrier_complete(unsigned* bar, unsigned x, unsigned& nloc, unsigned& nx) {
    const unsigned G = gridDim.x * gridDim.y * gridDim.z;
    unsigned sum, cnt, mine, sp = 0u;
    for (;;) {
        sum = 0u; cnt = 0u; mine = 0u;
#pragma unroll
        for (unsigned j = 0; j < 16; ++j) { const unsigned c = xb_ld(&bar[XB_XCNT(j)]); sum += c; cnt += (c > 0u) ? 1u : 0u; mine = (j == x) ? c : mine; }
        if (sum == G) break;
        __builtin_amdgcn_s_sleep(1);
        if ((++sp & 255u) == 0u) { if (xb_ld(&bar[XB_TMO])) break; if (sp > XB_SPIN_CAP) { atomicAdd(&bar[XB_TMO], 1u); break; } }
    }
    nloc = mine > 0u ? mine : 1u; nx = cnt > 0u ? cnt : 1u;
}
__device__ __forceinline__ void xcd_barrier(const XcdBarrier& b, const int wv) {
    asm volatile("s_waitcnt vmcnt(0)" ::: "memory");
    __syncthreads();
    if (wv == 0 && lane_id_asm() == 0) {
        unsigned* bar = b.bar;
        __builtin_amdgcn_s_waitcnt(0);
        unsigned nloc = b.st[0], nx = b.st[1];
        if (nloc == 0u) { xcd_barrier_complete(bar, b.x, nloc, nx); b.st[0] = nloc; b.st[1] = nx; }
        const unsigned old = xb_add(&bar[XB_XSUB(b.x)], 1u);
        const unsigned gen = old / nloc;
        if (old + 1u == (gen + 1u) * nloc) {
            __builtin_amdgcn_fence(__ATOMIC_RELEASE, "agent");
            asm volatile("s_waitcnt vmcnt(0)" ::: "memory");
            const unsigned og = xb_add(&bar[XB_TOP], 1u);
            const unsigned tg = og / nx;
            if (og + 1u == (tg + 1u) * nx) xb_add(&bar[XB_TOPGEN], 1u);
            else XB_SPIN(xb_ld(&bar[XB_TOPGEN]) == tg, bar);
            __builtin_amdgcn_fence(__ATOMIC_ACQUIRE, "agent");
            xb_add(&bar[XB_XGEN(b.x)], 1u);
            asm volatile("s_waitcnt vmcnt(0)" ::: "memory");
        } else {
            XB_SPIN(xb_ld(&bar[XB_XGEN(b.x)]) == gen, bar);
            __builtin_amdgcn_fence(__ATOMIC_ACQUIRE, "agent");
            asm volatile("s_waitcnt vmcnt(0)" ::: "memory");
        }
    }
    __syncthreads();
}

constexpr int NPHASES = 9;
struct Args { const float* in[16]; float* out; unsigned char* ws; int ph_lo, ph_hi; };
#ifndef PROBE_DUP
#define PROBE_DUP -1
#endif
#ifndef MK_N_LAUNCHES
#define MK_N_LAUNCHES 1
#endif

__global__ void __launch_bounds__(NTHREADS, 2) hybrid_fwd(Args args) {
    extern __shared__ __attribute__((aligned(16))) unsigned char lds_raw[];
    LAS unsigned char* lds = (LAS unsigned char*)lds_raw;
    cg::grid_group grid = cg::this_grid();
    volatile LAS unsigned* misc = (volatile LAS unsigned*)(lds + LDS_BYTES - 64);
    if (threadIdx.x < 16) misc[threadIdx.x] = 0u;
    __syncthreads();
    const int wv = __builtin_amdgcn_readfirstlane(threadIdx.x >> 6);
    XcdBarrier xbar = xcd_barrier_post((unsigned*)(args.ws + WS_CTL), misc, (int)threadIdx.x);
    if (args.ph_lo == -12345) grid.sync();
    const int G = gridDim.x, bx = blockIdx.x;
    const int vcu = (G % 8 == 0) ? (bx % 8) * (G / 8) + bx / 8 : bx;
    Ptrs P;
    P.x = args.in[0]; P.p = args.in[1]; P.g_mix = args.in[2]; P.w_in = args.in[3]; P.g_q = args.in[4]; P.g_k = args.in[5]; P.w_conv = args.in[6]; P.w_ao = args.in[7];
    P.w_co = args.in[8]; P.w_o = args.in[9]; P.g_mlp = args.in[10]; P.w_up = args.in[11]; P.w_dn = args.in[12]; P.g_ple = args.in[13]; P.w_g = args.in[14]; P.w_pp = args.in[15];
    P.out = args.out; P.ws = args.ws;
    unsigned char* ws = args.ws;
    const int lo = args.ph_lo, hi = args.ph_hi;
#define IN(k) (lo <= (k) && (k) < hi)
#define SEAM(k) do { if (IN(k) && IN((k) + 1)) { xcd_barrier(xbar, wv); if (PROBE_DUP == 9) { xcd_barrier(xbar, wv); xcd_barrier(xbar, wv); } } } while (0)
    using namespace pg8;

    if (IN(0)) { const int t0 = wv * 64 + lane_id_asm(); p0_prologue(P, lds, vcu, G, wv, t0 & 63);
        if (PROBE_DUP == 0) { __syncthreads(); p0_prologue(P, lds, vcu, G, wv, t0 & 63); } }
    SEAM(0);
    if (IN(1)) {
        Gemm g{(const bf16_t*)(ws + WS_HB), (const bf16_t*)(ws + WS_WIN), M, NZ, D}; StaticOrder S; S.init(M, NZ, G, bx);
        EpiZ E{ws};
        gemm_phase<EpiZ, StaticOrder, true, true>(lds, g, S, E, wv);
        if (PROBE_DUP == 1) gemm_phase<EpiZ, StaticOrder, true, true>(lds, g, S, E, wv);
    }
    SEAM(1);
    if (IN(2)) { const int t2 = wv * 64 + lane_id_asm(); if (PROBE_DUP == 2) { for (int it = vcu; it < BATCH * NBLK * NH; it += G) p2_unit(P, lds, it, t2, (bf16_t*)(ws + WS_WIN), (bf16_t*)(ws + WS_WIN + 16 * MiB), (bf16_t*)(ws + WS_HB)); }
        for (int it = vcu; it < BATCH * NBLK * NH; it += G) p2_unit(P, lds, it, t2, (bf16_t*)(ws + WS_Q), (bf16_t*)(ws + WS_K), (bf16_t*)(ws + WS_CB)); }
    SEAM(2);
    if (IN(3)) { const int t3 = wv * 64 + lane_id_asm(); for (int rep3 = (PROBE_DUP == 3 ? 0 : 1); rep3 < 2; ++rep3) { bf16_t* Ob = (bf16_t*)(ws + (rep3 ? WS_Q : WS_CC));
            for (int u = vcu; u < BATCH * NH * NBLK; u += G) { const int bh = u >> 4, j = u & 15;
#pragma unroll 1
                for (int k = 0; k < 2; ++k) attn_unit(P, lds, bh, k ? j : 15 - j, k ? 0 : 1, t3, Ob); } }
        late_weight_steal(P, lds, (unsigned*)(ws + WS_CTL) + XCD_BAR_WORDS + 64, wv, t3 & 63); }
    SEAM(3);
    for (int rep4 = 0; rep4 < (PROBE_DUP == 4 ? 2 : 1); ++rep4)
    if (IN(4)) {
        { Gemm g{(const bf16_t*)(ws + WS_CB), (const bf16_t*)(ws + WS_WCO), M, D, CW}; StaticOrder S; S.init(M, D, G, bx);
          EpiConvPart E{(const bf16_t*)(ws + WS_SC), (bf16_t*)(ws + WS_T1)};
          gemm_phase<EpiConvPart, StaticOrder, true, true>(lds, g, S, E, wv); }
        { Gemm g{(const bf16_t*)(ws + WS_Q), (const bf16_t*)(ws + WS_WAO), M, D, AW}; StaticOrder S; S.init(M, D, G, bx);
          EpiMerged E{(const bf16_t*)(ws + WS_SA), (const bf16_t*)(ws + WS_T1), (bf16_t*)(ws + WS_MERGED)};
          gemm_phase<EpiMerged, StaticOrder, true, true>(lds, g, S, E, wv); }
    }
    SEAM(4);
    if (IN(5)) {
        Gemm g{(const bf16_t*)(ws + WS_MERGED), (const bf16_t*)(ws + WS_WO), M, D, D}; StaticOrder S; S.init(M, D, G, bx);
        EpiResid<false> E{P.x, (bf16_t*)(ws + WS_R1B), (float*)(ws + WS_ST1)};
        gemm_phase<EpiResid<false>, StaticOrder, false, true>(lds, g, S, E, wv);
    }
    SEAM(5);
    if (IN(6)) {
        Gemm g{(const bf16_t*)(ws + WS_R1B), (const bf16_t*)(ws + WS_WUP), M, FF, D}; StaticOrder S; S.init(M, FF, G, bx);
        EpiUp E{(const float*)(ws + WS_ST1), (bf16_t*)(ws + WS_ACT)};
        gemm_phase<EpiUp, StaticOrder, true, true>(lds, g, S, E, wv);
        if (PROBE_DUP == 6) gemm_phase<EpiUp, StaticOrder, true, true>(lds, g, S, E, wv);
    }
    SEAM(6);
    if (IN(7)) {
        Gemm g{(const bf16_t*)(ws + WS_ACT), (const bf16_t*)(ws + WS_WDN), M, D, FF}; StaticOrder S; S.init(M, D, G, bx);
        EpiResid<true> E{(const bf16_t*)(ws + WS_R1B), (bf16_t*)(ws + WS_R2B), (float*)(ws + WS_ST2)};
        gemm_phase<EpiResid<true>, StaticOrder, false, true>(lds, g, S, E, wv);
    }
    SEAM(7);
    if (IN(8)) {
        { Gemm g{(const bf16_t*)(ws + WS_PB), (const bf16_t*)(ws + WS_WPP), M, D, PLE}; StaticOrder S; S.init(M, D, G, bx);
          EpiStoreBf16 E{(bf16_t*)(ws + WS_T2)};
          gemm_phase<EpiStoreBf16, StaticOrder, true, true>(lds, g, S, E, wv); }
        { Gemm g{(const bf16_t*)(ws + WS_R2B), (const bf16_t*)(ws + WS_WG), M, D, D}; StaticOrder S; S.init(M, D, G, bx);
          EpiOut E{(const float*)(ws + WS_ST2), (const bf16_t*)(ws + WS_T2), (const bf16_t*)(ws + WS_R2B), P.out};
          gemm_phase<EpiOut, StaticOrder, true, true>(lds, g, S, E, wv); }
    }
#undef IN
#undef SEAM
}

extern "C" void kernel_launch(void* const* d_in, const int* in_sizes, int n_in, void* d_out, int out_size, void* d_ws, size_t ws_size, hipStream_t stream) {
    static int grid = 0;
    if (grid == 0) {
        if (n_in != 16 || in_sizes[0] != M * D || out_size != M * D || ws_size < WS_END) { fprintf(stderr, "kernel_launch: unexpected shapes (n_in %d, in0 %d, out %d, ws %zu); nothing launched\n", n_in, n_in > 0 ? in_sizes[0] : -1, out_size, ws_size); grid = -1; return; }
        int dev = 0, cus = 0, per_cu = 0;
        if (hipGetDevice(&dev) != hipSuccess || hipDeviceGetAttribute(&cus, hipDeviceAttributeMultiprocessorCount, dev) != hipSuccess) { fprintf(stderr, "kernel_launch: device query failed\n"); grid = -1; return; }
        if (hipFuncSetAttribute((const void*)hybrid_fwd, hipFuncAttributeMaxDynamicSharedMemorySize, LDS_BYTES) != hipSuccess) { fprintf(stderr, "kernel_launch: hipFuncSetAttribute failed\n"); grid = -1; return; }
        if (hipOccupancyMaxActiveBlocksPerMultiprocessor(&per_cu, (const void*)hybrid_fwd, NTHREADS, LDS_BYTES) != hipSuccess || per_cu < 1) { fprintf(stderr, "kernel_launch: occupancy query says %d blocks per CU\n", per_cu); per_cu = 1; }
        (void)hipGetLastError();
        grid = cus * 1;
    }
    if (grid < 0) return;
    if (hipMemsetAsync((char*)d_ws + WS_CTL, 0, CTL_ZERO_BYTES, stream) != hipSuccess) { fprintf(stderr, "kernel_launch: memset of the barrier words failed\n"); return; }
    Args a{};
    for (int i = 0; i < 16; ++i) a.in[i] = (const float*)d_in[i];
    a.out = (float*)d_out; a.ws = (unsigned char*)d_ws;
    constexpr int NL = MK_N_LAUNCHES;
    for (int li = 0; li < NL; ++li) {
        a.ph_lo = (NL == 1) ? 0 : li; a.ph_hi = (NL == 1) ? NPHASES : li + 1;
        void* kargs[] = {&a};
        const hipError_t e = hipLaunchCooperativeKernel((const void*)hybrid_fwd, dim3(grid), dim3(NTHREADS), kargs, LDS_BYTES, stream);
        if (e != hipSuccess) { fprintf(stderr, "kernel_launch: cooperative launch %d failed: %s (grid %d)\n", li, hipGetErrorString(e), grid); break; }
    }
}
```

```cpp
#include <hip/hip_runtime.h>
#include <hip/hip_cooperative_groups.h>
#include <cstdio>
#include <cstdint>
namespace cg = cooperative_groups;

#define LAS __attribute__((address_space(3)))
#define GAS __attribute__((address_space(1)))
typedef unsigned short bf16_t;
typedef short bf16x8 __attribute__((ext_vector_type(8)));
typedef float f32x4 __attribute__((ext_vector_type(4)));
typedef float f32x2 __attribute__((ext_vector_type(2)));
typedef float f32x16 __attribute__((ext_vector_type(16)));
typedef unsigned u32x4 __attribute__((ext_vector_type(4)));
typedef unsigned u32x2 __attribute__((ext_vector_type(2)));

constexpr int BATCH = 2, SEQ = 4096, M = BATCH * SEQ, D = 2048, NH = 8, HD = 128, AW = 1024, CW = 1024, FF = 8192, PLE = 256;
constexpr int NZ = 10240, MOBA_BLK = 256, NBLK = SEQ / MOBA_BLK, TOPK = 3;
constexpr float RMS_EPS = 1e-6f;
constexpr float LOG2E = 1.4426950408889634f;
constexpr float QSCALE = 0.08838834764831845f * LOG2E;
constexpr int NWAVES = 8, NTHREADS = 512;
constexpr int LDS_BYTES = 147456;

constexpr size_t MiB = 1u << 20;
constexpr size_t WS_Q = 0 * MiB, WS_K = 16 * MiB, WS_CB = 32 * MiB, WS_SA = 48 * MiB, WS_SC = 80 * MiB, WS_V = 112 * MiB, WS_CC = 128 * MiB, WS_CX = 144 * MiB;
constexpr size_t WS_HB = 160 * MiB;
constexpr size_t WS_VT = 176 * MiB;
constexpr size_t WS_T1 = 112 * MiB;
constexpr size_t WS_R1B = 160 * MiB;
constexpr size_t WS_ACT = 0 * MiB;
constexpr size_t WS_R2B = 128 * MiB;
constexpr size_t WS_T2 = 0 * MiB;
constexpr size_t WS_WIN = 192 * MiB, WS_WUP = 232 * MiB, WS_WDN = 264 * MiB, WS_WO = 296 * MiB, WS_WG = 304 * MiB, WS_WAO = 312 * MiB, WS_WCO = 316 * MiB, WS_WPP = 320 * MiB;
constexpr size_t WS_MERGED = 192 * MiB;
constexpr size_t WS_PB = 321 * MiB;
constexpr size_t WS_ST1 = 325 * MiB;
constexpr size_t WS_ST2 = WS_ST1 + 256 * 1024;
constexpr size_t WS_KMEAN = WS_ST2 + 256 * 1024;
constexpr size_t WS_CTL = 326 * MiB, CTL_ZERO_BYTES = 16384;
constexpr size_t WS_END = 327 * MiB;

__device__ __forceinline__ unsigned cvt_pk_bf16(float lo, float hi) { unsigned r; asm volatile("v_cvt_pk_bf16_f32 %0, %1, %2" : "=v"(r) : "v"(lo), "v"(hi)); return r; }
__device__ __forceinline__ int lane_id_asm() { int l; asm volatile("v_mbcnt_lo_u32_b32 %0, -1, 0\n\tv_mbcnt_hi_u32_b32 %0, -1, %0" : "=v"(l)); return l; }
__device__ __forceinline__ float bf_lo(unsigned u) { return __uint_as_float(u << 16); }
__device__ __forceinline__ float bf_hi(unsigned u) { return __uint_as_float(u & 0xffff0000u); }
__device__ __forceinline__ float sigmoidf_fast(float x) { return __builtin_amdgcn_rcpf(1.0f + __builtin_amdgcn_exp2f(-x * LOG2E)); }

namespace pg8 {
constexpr int BM = 256, BK = 64, HALF = 128, HTB = HALF * BK * 2  , STAGE_BYTES = 8 * HTB, NXCD = 8, WGM = 8;
__host__ __device__ __forceinline__ int lds_byte(int r, int c) { const int st = (r >> 4) * 2 + (c >> 5), rr = r & 15, cc = c & 31, ob = rr * 64 + cc * 2; return st * 1024 + (ob ^ (((ob >> 9) & 1) << 5)); }
__host__ __device__ __forceinline__ void stage_rc(int b, int& R, int& C) { const int st = b / 1024, sb = b % 1024, swz = sb ^ (((sb >> 9) & 1) << 5); R = (st >> 1) * 16 + swz / 64; C = (st & 1) * 32 + (swz % 64) / 2; }
__host__ __device__ __forceinline__ int perm32(int rho) { const int n = rho >> 4, i = rho & 15; return 8 * (i >> 2) + 4 * n + (i & 3); }

struct Unit { int pm, pn; };
struct Gemm { const bf16_t* A; const bf16_t* Bt; int M, N, K; };

struct StaticOrder {
    int nM, nN, nwg, G, c;
    __host__ __device__ void init(int M_, int N_, int G_, int c_) { nM = M_ / BM; nN = N_ / BM; nwg = nM * nN; G = G_; c = c_; }
    __host__ __device__ bool next(int i, Unit& u) const {
        const long L = (long)i * G + c; if (L >= nwg) return false;
        int wgid = (int)L; { const int q = nwg / NXCD, r = nwg % NXCD, xcd = wgid % NXCD, off = wgid / NXCD; wgid = (xcd < r ? xcd * (q + 1) : r * (q + 1) + (xcd - r) * q) + off; }
        const int nig = WGM * nN, gid = wgid / nig, fm = gid * WGM, gsz = (nM - fm) < WGM ? (nM - fm) : WGM;
        u.pm = fm + ((wgid % nig) % gsz); u.pn = (wgid % nig) / gsz; return true;
    }
    __device__ __forceinline__ void a_ready(const Unit&) const {}
    __device__ __forceinline__ void done(const Unit&) const {}
};

typedef f32x4 Acc[2][2][4][2];

struct EpiZ {
    static constexpr bool PERM = true, AFTER_DRAIN = false;
    unsigned char* ws;
    __device__ __forceinline__ void operator()(const Acc& acc, const Unit& u, int wr, int wc, int fr, int fq) const {
        const int pn = u.pn; const int seg = pn < 24 ? (pn >> 2) : (pn < 32 ? 6 : 7);
        const size_t boff = seg == 0 ? WS_Q : seg == 1 ? WS_K : seg == 2 ? WS_V : seg == 3 ? WS_CB : seg == 4 ? WS_CC : seg == 5 ? WS_CX : seg == 6 ? WS_SA : WS_SC;
        const int ldc = seg < 6 ? 1024 : 2048; const int colt = seg < 6 ? (pn & 3) * 256 : ((pn - 24) & 7) * 256; const bool sg = seg >= 6;
        bf16_t* base = (bf16_t*)(ws + boff);
        const int row0 = u.pm * BM + wr * 64 + fr, col0 = colt + wc * 32 + 8 * fq;
#pragma unroll
        for (int ai = 0; ai < 2; ++ai)
#pragma unroll
            for (int m = 0; m < 4; ++m) { bf16_t* rowp = base + (size_t)(row0 + ai * HALF + m * 16) * ldc + col0;
#pragma unroll
                for (int bj = 0; bj < 2; ++bj) { f32x4 v0 = acc[ai][bj][m][0], v1 = acc[ai][bj][m][1];
                    if (sg) {
#pragma unroll
                        for (int j = 0; j < 4; ++j) { v0[j] = sigmoidf_fast(v0[j]); v1[j] = sigmoidf_fast(v1[j]); } }
                    u32x4 w; w.x = cvt_pk_bf16(v0[0], v0[1]); w.y = cvt_pk_bf16(v0[2], v0[3]); w.z = cvt_pk_bf16(v1[0], v1[1]); w.w = cvt_pk_bf16(v1[2], v1[3]);
                    *(u32x4*)(rowp + bj * HALF) = w; } }
    }
};
struct EpiConvPart {
    static constexpr bool PERM = true, AFTER_DRAIN = false;
    const bf16_t* sc; bf16_t* t1;
    __device__ __forceinline__ void operator()(const Acc& acc, const Unit& u, int wr, int wc, int fr, int fq) const {
        const int row0 = u.pm * BM + wr * 64 + fr, col0 = u.pn * BM + wc * 32 + 8 * fq;
#pragma unroll
        for (int ai = 0; ai < 2; ++ai)
#pragma unroll
            for (int m = 0; m < 4; ++m) { const size_t off = (size_t)(row0 + ai * HALF + m * 16) * D + col0;
#pragma unroll
                for (int bj = 0; bj < 2; ++bj) { const u32x4 g = *(const u32x4*)(sc + off + bj * HALF);
                    f32x4 v0 = acc[ai][bj][m][0], v1 = acc[ai][bj][m][1];
                    v0[0] *= bf_lo(g.x); v0[1] *= bf_hi(g.x); v0[2] *= bf_lo(g.y); v0[3] *= bf_hi(g.y); v1[0] *= bf_lo(g.z); v1[1] *= bf_hi(g.z); v1[2] *= bf_lo(g.w); v1[3] *= bf_hi(g.w);
                    u32x4 w; w.x = cvt_pk_bf16(v0[0], v0[1]); w.y = cvt_pk_bf16(v0[2], v0[3]); w.z = cvt_pk_bf16(v1[0], v1[1]); w.w = cvt_pk_bf16(v1[2], v1[3]);
                    *(u32x4*)(t1 + off + bj * HALF) = w; }
                if (m & 1) asm volatile("" ::: "memory"); }
    }
};
struct EpiMerged {
    static constexpr bool PERM = true, AFTER_DRAIN = false;
    const bf16_t* sa; const bf16_t* t1; bf16_t* out;
    __device__ __forceinline__ void operator()(const Acc& acc, const Unit& u, int wr, int wc, int fr, int fq) const {
        const int row0 = u.pm * BM + wr * 64 + fr, col0 = u.pn * BM + wc * 32 + 8 * fq;
#pragma unroll
        for (int ai = 0; ai < 2; ++ai)
#pragma unroll
            for (int m = 0; m < 4; ++m) { const size_t off = (size_t)(row0 + ai * HALF + m * 16) * D + col0;
#pragma unroll
                for (int bj = 0; bj < 2; ++bj) { const u32x4 g = *(const u32x4*)(sa + off + bj * HALF);
                    const u32x4 tw = *(const u32x4*)(t1 + off + bj * HALF); const f32x4 a0 = (f32x4){bf_lo(tw.x), bf_hi(tw.x), bf_lo(tw.y), bf_hi(tw.y)}, a1 = (f32x4){bf_lo(tw.z), bf_hi(tw.z), bf_lo(tw.w), bf_hi(tw.w)};
                    f32x4 v0 = acc[ai][bj][m][0], v1 = acc[ai][bj][m][1];
                    v0[0] = v0[0] * bf_lo(g.x) + a0[0]; v0[1] = v0[1] * bf_hi(g.x) + a0[1]; v0[2] = v0[2] * bf_lo(g.y) + a0[2]; v0[3] = v0[3] * bf_hi(g.y) + a0[3];
                    v1[0] = v1[0] * bf_lo(g.z) + a1[0]; v1[1] = v1[1] * bf_hi(g.z) + a1[1]; v1[2] = v1[2] * bf_lo(g.w) + a1[2]; v1[3] = v1[3] * bf_hi(g.w) + a1[3];
                    u32x4 w; w.x = cvt_pk_bf16(v0[0], v0[1]); w.y = cvt_pk_bf16(v0[2], v0[3]); w.z = cvt_pk_bf16(v1[0], v1[1]); w.w = cvt_pk_bf16(v1[2], v1[3]);
                    *(u32x4*)(out + off + bj * HALF) = w; }
                if (m & 1) asm volatile("" ::: "memory"); }
    }
};
template <bool BASE_BF16> struct EpiResid {
    static constexpr bool PERM = false, AFTER_DRAIN = true;
    const void* base; bf16_t* rb; float* stats;
    __device__ __forceinline__ void fused(Acc& acc, const Unit& u, int wr, int wc, int fr, int fq, LAS unsigned char* lds, int wid, int lane) const {
        LAS float* P = (LAS float*)lds;
        const int col0 = u.pn * BM + wc * 32 + 4 * fq;
#pragma unroll
        for (int ai = 0; ai < 2; ++ai)
#pragma unroll
            for (int m = 0; m < 4; ++m) { const int rl = ai * HALF + wr * 64 + m * 16 + fr; const size_t off = (size_t)(u.pm * BM + rl) * D + col0; float s = 0.f;
#pragma unroll
                for (int bj = 0; bj < 2; ++bj)
#pragma unroll
                    for (int n = 0; n < 2; ++n) { f32x4 b;
                        if (BASE_BF16) { const u32x2 bw = *(const u32x2*)((const bf16_t*)base + off + bj * HALF + n * 16); b = (f32x4){bf_lo(bw.x), bf_hi(bw.x), bf_lo(bw.y), bf_hi(bw.y)}; }
                        else b = *(const f32x4*)((const float*)base + off + bj * HALF + n * 16);
                        const f32x4 v = acc[ai][bj][m][n] + b;
                        u32x2 w; w.x = cvt_pk_bf16(v[0], v[1]); w.y = cvt_pk_bf16(v[2], v[3]); *(u32x2*)(rb + off + bj * HALF + n * 16) = w;
                        s += (v[0] * v[0] + v[1] * v[1]) + (v[2] * v[2] + v[3] * v[3]); }
                s += __shfl_xor(s, 16); s += __shfl_xor(s, 32);
                if (fq == 0) P[rl * 4 + wc] = s;
                asm volatile("" ::: "memory"); }
        __syncthreads();
        const int t = wid * 64 + lane;
        if (t < 256) { const float s = (P[t * 4 + 0] + P[t * 4 + 1]) + (P[t * 4 + 2] + P[t * 4 + 3]); stats[(size_t)(u.pm * BM + t) * 8 + u.pn] = s; }
        __syncthreads();
    }
};
__device__ __forceinline__ float row_rstd(const float* stats, int row) {
    const f32x4 a = *(const f32x4*)(stats + (size_t)row * 8), b = *(const f32x4*)(stats + (size_t)row * 8 + 4);
    const float s = ((a[0] + a[1]) + (a[2] + a[3])) + ((b[0] + b[1]) + (b[2] + b[3]));
    return __builtin_amdgcn_rsqf(s * (1.0f / D) + RMS_EPS);
}
struct EpiUp {
    static constexpr bool PERM = true, AFTER_DRAIN = false;
    const float* stats; bf16_t* out;
    __device__ __forceinline__ void operator()(const Acc& acc, const Unit& u, int wr, int wc, int fr, int fq) const {
        const int row0 = u.pm * BM + wr * 64 + fr, col0 = u.pn * BM + wc * 32 + 8 * fq;
#pragma unroll
        for (int ai = 0; ai < 2; ++ai)
#pragma unroll
            for (int m = 0; m < 4; ++m) { const int row = row0 + ai * HALF + m * 16; const float rs = row_rstd(stats, row); bf16_t* rowp = out + (size_t)row * FF + col0;
#pragma unroll
                for (int bj = 0; bj < 2; ++bj) { f32x4 v0 = acc[ai][bj][m][0] * rs, v1 = acc[ai][bj][m][1] * rs;
#pragma unroll
                    for (int j = 0; j < 4; ++j) { v0[j] = fmaxf(v0[j], 0.f); v0[j] *= v0[j]; v1[j] = fmaxf(v1[j], 0.f); v1[j] *= v1[j]; }
                    u32x4 w; w.x = cvt_pk_bf16(v0[0], v0[1]); w.y = cvt_pk_bf16(v0[2], v0[3]); w.z = cvt_pk_bf16(v1[0], v1[1]); w.w = cvt_pk_bf16(v1[2], v1[3]);
                    *(u32x4*)(rowp + bj * HALF) = w; } }
    }
};
struct EpiStoreBf16 {
    static constexpr bool PERM = false, AFTER_DRAIN = false;
    bf16_t* t2;
    __device__ __forceinline__ void operator()(const Acc& acc, const Unit& u, int wr, int wc, int fr, int fq) const {
        const int col0 = u.pn * BM + wc * 32 + 4 * fq;
#pragma unroll
        for (int ai = 0; ai < 2; ++ai)
#pragma unroll
            for (int m = 0; m < 4; ++m) { const size_t off = (size_t)(u.pm * BM + ai * HALF + wr * 64 + m * 16 + fr) * D + col0;
#pragma unroll
                for (int bj = 0; bj < 2; ++bj)
#pragma unroll
                    for (int n = 0; n < 2; ++n) { const f32x4 v = acc[ai][bj][m][n]; u32x2 w; w.x = cvt_pk_bf16(v[0], v[1]); w.y = cvt_pk_bf16(v[2], v[3]); *(u32x2*)(t2 + off + bj * HALF + n * 16) = w; } }
    }
};
struct EpiOut {
    static constexpr bool PERM = false, AFTER_DRAIN = false;
    const float* stats; const bf16_t* t2; const bf16_t* rin; float* out;
    __device__ __forceinline__ void operator()(const Acc& acc, const Unit& u, int wr, int wc, int fr, int fq) const {
        const int col0 = u.pn * BM + wc * 32 + 4 * fq;
#pragma unroll
        for (int ai = 0; ai < 2; ++ai)
#pragma unroll
            for (int m = 0; m < 4; ++m) { const int row = u.pm * BM + ai * HALF + wr * 64 + m * 16 + fr; const size_t off = (size_t)row * D + col0; const float rs = row_rstd(stats, row);
#pragma unroll
                for (int bj = 0; bj < 2; ++bj)
#pragma unroll
                    for (int n = 0; n < 2; ++n) { const u32x2 rw = *(const u32x2*)(rin + off + bj * HALF + n * 16), tw = *(const u32x2*)(t2 + off + bj * HALF + n * 16); const f32x4 r = (f32x4){bf_lo(rw.x), bf_hi(rw.x), bf_lo(rw.y), bf_hi(rw.y)}, t = (f32x4){bf_lo(tw.x), bf_hi(tw.x), bf_lo(tw.y), bf_hi(tw.y)}; f32x4 v = acc[ai][bj][m][n] * rs;
#pragma unroll
                        for (int j = 0; j < 4; ++j) v[j] = r[j] + sigmoidf_fast(v[j]) * t[j];
                        *(f32x4*)(out + off + bj * HALF + n * 16) = v; }
                if (m & 1) asm volatile("" ::: "memory"); }
    }
};

#define PG8_LAS LAS
template <class Epi, class Sched, bool ALIGN_EPI = false, bool SP2 = false>
__device__ __forceinline__ void gemm_phase(PG8_LAS unsigned char* lds, const Gemm g, const Sched& S, const Epi& E, const int wv) {
    const int tid_ = wv * 64 + lane_id_asm();
    const int tid = tid_, wid = wv, lane = tid & 63, wr = wid >> 2, wc = wid & 3, fr = lane & 15, fq = lane >> 4;
    const int K = g.K, nt = K / BK;
    unsigned voffA[2], voffB[2];
#pragma unroll
    for (int i = 0; i < 2; ++i) { int R, C; stage_rc(tid * 16 + i * 8192, R, C); const int Rb = Epi::PERM ? ((R & ~31) + perm32(R & 31)) : R;
        voffA[i] = (unsigned)(R * K + C) * 2u; voffB[i] = (unsigned)(Rb * K + C) * 2u; }
    const size_t kstep = (size_t)(BK * 2);
    const size_t hstep = (size_t)HALF * K * 2;
    const size_t tstep = 2 * hstep;
    const unsigned ldsw = (unsigned)wid * 1024u;
    const int aoff = lds_byte(wr * 64 + fr, fq * 8), boff = lds_byte(wc * 32 + fr, fq * 8);
#define PG8_SA(b, h) (((b) * 2 + (h)) * HTB)
#define PG8_SB(b, h) ((4 + (b) * 2 + (h)) * HTB)
#define PG8_STAGE(bufoff, gbase, voff) do { _Pragma("unroll") for (int _i = 0; _i < 2; ++_i) \
        __builtin_amdgcn_global_load_lds((const unsigned*)((const char*)(gbase) + (voff)[_i]), (PG8_LAS unsigned*)(lds + (bufoff) + ldsw + _i * 8192), 16, 0, 0); } while (0)
#define PG8_LDA(dst, b, h) do { _Pragma("unroll") for (int m = 0; m < 4; ++m) _Pragma("unroll") for (int k = 0; k < 2; ++k) dst[m][k] = *(const PG8_LAS bf16x8*)(lds + PG8_SA(b, h) + aoff + m * 2048 + k * 1024); } while (0)
#define PG8_LDB(dst, b, h) do { _Pragma("unroll") for (int n = 0; n < 2; ++n) _Pragma("unroll") for (int k = 0; k < 2; ++k) dst[n][k] = *(const PG8_LAS bf16x8*)(lds + PG8_SB(b, h) + boff + n * 2048 + k * 1024); } while (0)
#define PG8_MMA(ai, bj, At, Bt) do { __builtin_amdgcn_s_setprio(1); _Pragma("unroll") for (int m = 0; m < 4; ++m) _Pragma("unroll") for (int n = 0; n < 2; ++n) _Pragma("unroll") for (int k = 0; k < 2; ++k) \
        acc[ai][bj][m][n] = __builtin_amdgcn_mfma_f32_16x16x32_bf16(Bt[n][k], At[m][k], acc[ai][bj][m][n], 0, 0, 0); __builtin_amdgcn_s_setprio(0); } while (0)
#define PG8_WAIT_V(n) asm volatile("s_waitcnt vmcnt(" #n ")" ::: "memory")
#define PG8_WAIT_L(n) asm volatile("s_waitcnt lgkmcnt(" #n ")" ::: "memory")
#define PG8_BAR __builtin_amdgcn_s_barrier()
#define PG8_SCHED __builtin_amdgcn_sched_barrier(0)
    Unit cur, nxt; int ui = 0;
    if (!S.next(0, cur)) return;
    f32x4 acc[2][2][4][2];
#pragma unroll
    for (int a = 0; a < 2; ++a)
#pragma unroll
        for (int b = 0; b < 2; ++b)
#pragma unroll
            for (int m = 0; m < 4; ++m)
#pragma unroll
                for (int n = 0; n < 2; ++n) acc[a][b][m][n] = (f32x4){0.f, 0.f, 0.f, 0.f};
    bf16x8 At[4][2], B0[2][2], B1[2][2];
    const char* cA = (const char*)g.A + (size_t)cur.pm * tstep; const char* cB = (const char*)g.Bt + (size_t)cur.pn * tstep;
    S.a_ready(cur);
    if constexpr (SP2) {
        PG8_STAGE(PG8_SB(0, 0), cB, voffB); PG8_STAGE(PG8_SB(0, 1), cB + hstep, voffB); PG8_STAGE(PG8_SA(0, 0), cA, voffA); PG8_STAGE(PG8_SA(0, 1), cA + hstep, voffA);
        if (wr == 1) PG8_BAR;
        PG8_WAIT_V(2); PG8_BAR;
        PG8_STAGE(PG8_SB(1, 0), cB + kstep, voffB); PG8_STAGE(PG8_SA(1, 0), cA + kstep, voffA); PG8_STAGE(PG8_SB(1, 1), cB + hstep + kstep, voffB);
        PG8_WAIT_V(6); PG8_BAR;
    } else {
        PG8_STAGE(PG8_SB(0, 0), cB, voffB); PG8_STAGE(PG8_SA(0, 0), cA, voffA); PG8_STAGE(PG8_SB(0, 1), cB + hstep, voffB); PG8_STAGE(PG8_SA(0, 1), cA + hstep, voffA);
        if (wr == 1) PG8_BAR;
        PG8_WAIT_V(4); PG8_BAR;
        PG8_STAGE(PG8_SB(1, 0), cB + kstep, voffB); PG8_STAGE(PG8_SA(1, 0), cA + kstep, voffA); PG8_STAGE(PG8_SB(1, 1), cB + hstep + kstep, voffB);
        PG8_WAIT_V(6); PG8_BAR;
    }
    for (;;) {
        const bool has_next = S.next(ui + 1, nxt);
        const char* nA = has_next ? (const char*)g.A + (size_t)nxt.pm * tstep : cA; const char* nB = has_next ? (const char*)g.Bt + (size_t)nxt.pn * tstep : cB;
        for (int t = 0; t < nt; t += 2) {
            const bool last = (t == nt - 2);
            const char* a1 = cA + (size_t)(t + 1) * kstep;
            const char* a2 = last ? nA : cA + (size_t)(t + 2) * kstep; const char* b2 = last ? nB : cB + (size_t)(t + 2) * kstep;
            const char* a3 = a2 + kstep; const char* b3 = b2 + kstep;
            if (last && has_next) S.a_ready(nxt);
            if constexpr (SP2) {
            PG8_LDB(B0, 0, 0); PG8_LDB(B1, 0, 1); PG8_SCHED; PG8_LDA(At, 0, 0); PG8_STAGE(PG8_SA(1, 1), a1 + hstep, voffA);
            PG8_WAIT_V(8); PG8_WAIT_L(0); PG8_BAR; PG8_MMA(0, 0, At, B0); PG8_MMA(0, 1, At, B1); PG8_BAR; PG8_SCHED;
            PG8_LDA(At, 0, 1); PG8_STAGE(PG8_SB(0, 0), b2, voffB); PG8_STAGE(PG8_SB(0, 1), b2 + hstep, voffB); PG8_STAGE(PG8_SA(0, 0), a2, voffA);
            PG8_WAIT_V(8); PG8_WAIT_L(0); PG8_BAR; PG8_MMA(1, 0, At, B0); PG8_MMA(1, 1, At, B1); PG8_BAR; PG8_SCHED;
            PG8_LDB(B0, 1, 0); PG8_LDB(B1, 1, 1); PG8_SCHED; PG8_LDA(At, 1, 0); PG8_STAGE(PG8_SA(0, 1), a2 + hstep, voffA);
            PG8_WAIT_V(8); PG8_WAIT_L(0); PG8_BAR; PG8_MMA(0, 0, At, B0); PG8_MMA(0, 1, At, B1); PG8_BAR; PG8_SCHED;
            PG8_LDA(At, 1, 1); PG8_STAGE(PG8_SB(1, 0), b3, voffB); PG8_STAGE(PG8_SB(1, 1), b3 + hstep, voffB); PG8_STAGE(PG8_SA(1, 0), a3, voffA);
            PG8_WAIT_V(8); PG8_WAIT_L(0); PG8_BAR; PG8_MMA(1, 0, At, B0); PG8_MMA(1, 1, At, B1); PG8_BAR; PG8_SCHED;
            } else {
            PG8_LDB(B0, 0, 0); PG8_SCHED; PG8_LDA(At, 0, 0); PG8_STAGE(PG8_SA(1, 1), a1 + hstep, voffA);
            PG8_WAIT_L(8); PG8_BAR; PG8_WAIT_L(0); PG8_MMA(0, 0, At, B0); PG8_BAR; PG8_SCHED;
            PG8_LDB(B1, 0, 1); PG8_STAGE(PG8_SB(0, 0), b2, voffB);
            PG8_BAR; PG8_WAIT_L(0); PG8_MMA(0, 1, At, B1); PG8_BAR;
            PG8_LDA(At, 0, 1); PG8_STAGE(PG8_SA(0, 0), a2, voffA);
            PG8_BAR; PG8_WAIT_L(0); PG8_MMA(1, 0, At, B0); PG8_BAR; PG8_SCHED;
            PG8_STAGE(PG8_SB(0, 1), b2 + hstep, voffB);
            PG8_WAIT_V(6); PG8_BAR; PG8_MMA(1, 1, At, B1); PG8_BAR;
            PG8_LDB(B0, 1, 0); PG8_SCHED; PG8_LDA(At, 1, 0); PG8_STAGE(PG8_SA(0, 1), a2 + hstep, voffA);
            PG8_WAIT_L(8); PG8_BAR; PG8_WAIT_L(0); PG8_MMA(0, 0, At, B0); PG8_BAR; PG8_SCHED;
            PG8_LDB(B1, 1, 1); PG8_STAGE(PG8_SB(1, 0), b3, voffB);
            PG8_BAR; PG8_WAIT_L(0); PG8_MMA(0, 1, At, B1); PG8_BAR;
            PG8_LDA(At, 1, 1); PG8_STAGE(PG8_SA(1, 0), a3, voffA);
            PG8_BAR; PG8_WAIT_L(0); PG8_MMA(1, 0, At, B0); PG8_BAR; PG8_SCHED;
            PG8_STAGE(PG8_SB(1, 1), b3 + hstep, voffB);
            PG8_WAIT_V(6); PG8_BAR; PG8_MMA(1, 1, At, B1); PG8_BAR;
            }
        }
        if constexpr (ALIGN_EPI) { if (wr == 0) PG8_BAR; }
        if constexpr (!Epi::AFTER_DRAIN) { E(acc, cur, wr, wc, fr, fq); S.done(cur); }
        if (!has_next) break;
#pragma unroll
        for (int a = 0; a < 2; ++a)
#pragma unroll
            for (int b = 0; b < 2; ++b)
#pragma unroll
                for (int m = 0; m < 4; ++m)
#pragma unroll
                    for (int n = 0; n < 2; ++n) acc[a][b][m][n] = (f32x4){0.f, 0.f, 0.f, 0.f};
        cur = nxt; cA = nA; cB = nB; ++ui;
        if constexpr (ALIGN_EPI) { if (wr == 1) PG8_BAR; }
    }
    PG8_WAIT_V(0);
    if constexpr (!ALIGN_EPI) { if (wr == 0) PG8_BAR; }
    PG8_BAR;
    if constexpr (Epi::AFTER_DRAIN) { E.fused(acc, cur, wr, wc, fr, fq, lds, wid, lane); S.done(cur); }
#undef PG8_SA
#undef PG8_SB
#undef PG8_STAGE
#undef PG8_LDA
#undef PG8_LDB
#undef PG8_MMA
#undef PG8_WAIT_V
#undef PG8_WAIT_L
#undef PG8_BAR
#undef PG8_SCHED
}
}

constexpr int RING_BYTES = 131072;

__device__ __forceinline__ float wave_sum(float v) {
#pragma unroll
    for (int o = 1; o < 64; o <<= 1) v += __shfl_xor(v, o);
    return v;
}
__device__ __forceinline__ float wave_max(float v) {
#pragma unroll
    for (int o = 1; o < 64; o <<= 1) v = fmaxf(v, __shfl_xor(v, o));
    return v;
}

struct TrDesc { const float* W; const float* g; bf16_t* WT; int K, N, k0, n0; };
template <int KT> struct TrTile {
    static constexpr int RPW = KT / 8, KCW = KT / 64;
    static __device__ __forceinline__ void load(const TrDesc& d, int wave, int lane, f32x4 (&v)[RPW]) {
        const float* src = d.W + (size_t)(d.k0 + wave * RPW) * d.N + d.n0 + lane * 4;
#pragma unroll
        for (int i = 0; i < RPW; ++i) v[i] = __builtin_nontemporal_load((const f32x4*)(src + (size_t)i * d.N));
    }
    static __device__ __forceinline__ void to_lds(const TrDesc& d, LAS float* scr, int wave, int lane, f32x4 (&v)[RPW]) {
#pragma unroll
        for (int i = 0; i < RPW; ++i) { f32x4 x = v[i]; if (d.g) x = x * d.g[d.k0 + wave * RPW + i]; *(LAS f32x4*)(scr + (wave * RPW + i) * 256 + lane * 4) = x; }
    }
    static __device__ __forceinline__ void store(const TrDesc& d, const LAS float* scr, int wave, int lane) {
#pragma unroll
        for (int c = 0; c < KCW; ++c) { const int kc = wave * KCW + c;
#pragma unroll
            for (int q = 0; q < 4; ++q) { const int n = lane + 64 * q; const LAS float* t = scr + (8 * kc) * 256 + n;
                u32x4 o; o.x = cvt_pk_bf16(t[0 * 256], t[1 * 256]); o.y = cvt_pk_bf16(t[2 * 256], t[3 * 256]); o.z = cvt_pk_bf16(t[4 * 256], t[5 * 256]); o.w = cvt_pk_bf16(t[6 * 256], t[7 * 256]);
                *(u32x4*)(d.WT + (size_t)(d.n0 + n) * d.K + d.k0 + 8 * kc) = o; } }
    }
};

struct Ptrs {
    const float *x, *p, *g_mix, *w_in, *g_q, *g_k, *w_conv, *w_ao, *w_co, *w_o, *g_mlp, *w_up, *w_dn, *g_ple, *w_g, *w_pp;
    float* out; unsigned char* ws;
};

constexpr int LT_AO = (AW / 128) * (D / 256), LT_CO = (CW / 128) * (D / 256), LT_O = (D / 128) * (D / 256), LT_UP = (D / 128) * (FF / 256), LT_DN = (FF / 128) * (D / 256), LT_G = LT_O, LT_PP = (PLE / 128) * (D / 256);
constexpr int N_LATE_ITEMS = LT_AO + LT_CO + LT_O + LT_UP + LT_DN + LT_G + LT_PP;
__device__ __forceinline__ TrDesc late_desc(const Ptrs& P, int it) {
    unsigned char* ws = P.ws; int r = it; TrDesc d;
    if (r < LT_AO) { d.W = P.w_ao; d.g = nullptr; d.WT = (bf16_t*)(ws + WS_WAO); d.K = AW; d.N = D; }
    else if ((r -= LT_AO) < LT_CO) { d.W = P.w_co; d.g = nullptr; d.WT = (bf16_t*)(ws + WS_WCO); d.K = CW; d.N = D; }
    else if ((r -= LT_CO) < LT_O) { d.W = P.w_o; d.g = nullptr; d.WT = (bf16_t*)(ws + WS_WO); d.K = D; d.N = D; }
    else if ((r -= LT_O) < LT_UP) { d.W = P.w_up; d.g = P.g_mlp; d.WT = (bf16_t*)(ws + WS_WUP); d.K = D; d.N = FF; }
    else if ((r -= LT_UP) < LT_DN) { d.W = P.w_dn; d.g = nullptr; d.WT = (bf16_t*)(ws + WS_WDN); d.K = FF; d.N = D; }
    else if ((r -= LT_DN) < LT_G) { d.W = P.w_g; d.g = P.g_ple; d.WT = (bf16_t*)(ws + WS_WG); d.K = D; d.N = D; }
    else { r -= LT_G; d.W = P.w_pp; d.g = nullptr; d.WT = (bf16_t*)(ws + WS_WPP); d.K = PLE; d.N = D; }
    const int nblk = d.N >> 8, kb = r / nblk, nb = r - kb * nblk; d.k0 = kb * 128; d.n0 = nb << 8;
    return d;
}
__device__ __forceinline__ void late_weight_steal(const Ptrs& P, LAS unsigned char* lds, unsigned* ctr, int wave, int lane) {
    LAS float* scr = (LAS float*)lds;
    volatile LAS unsigned* slot = (volatile LAS unsigned*)(lds + LDS_BYTES - 32);
    const bool t0 = (wave == 0 && lane == 0);
    if (t0) slot[0] = __hip_atomic_fetch_add(ctr, 1u, __ATOMIC_RELAXED, __HIP_MEMORY_SCOPE_AGENT);
    __syncthreads();
    unsigned it = __builtin_amdgcn_readfirstlane(slot[0]);
    if (it >= (unsigned)N_LATE_ITEMS) return;
    TrDesc d = late_desc(P, (int)it);
    f32x4 v[16];
    TrTile<128>::load(d, wave, lane, v);
    for (;;) {
        __syncthreads();
        TrTile<128>::to_lds(d, scr, wave, lane, v);
        if (t0) slot[0] = __hip_atomic_fetch_add(ctr, 1u, __ATOMIC_RELAXED, __HIP_MEMORY_SCOPE_AGENT);
        __syncthreads();
        const unsigned nxt = __builtin_amdgcn_readfirstlane(slot[0]);
        const bool more = nxt < (unsigned)N_LATE_ITEMS;
        TrDesc dn = d;
        if (more) { dn = late_desc(P, (int)nxt); TrTile<128>::load(dn, wave, lane, v); }
        TrTile<128>::store(d, scr, wave, lane);
        if (!more) break;
        d = dn;
    }
    __syncthreads();
}

__device__ __forceinline__ void p0_prologue(const Ptrs& P, LAS unsigned char* lds, int vcu, int G, int wave, int lane) {
    const int gw = vcu * NWAVES + wave, NGW = G * NWAVES;
    unsigned char* ws = P.ws;
    {
        constexpr int I0 = (D / 64) * (NZ / 256), NBLK_N = NZ / 256;
        LAS float* scr = (LAS float*)lds;
        int it = vcu;
        if (it < I0) {
            TrDesc d; d.W = P.w_in; d.g = P.g_mix; d.WT = (bf16_t*)(ws + WS_WIN); d.K = D; d.N = NZ; d.k0 = (it / NBLK_N) * 64; d.n0 = (it % NBLK_N) << 8;
            f32x4 v[8];
            TrTile<64>::load(d, wave, lane, v);
            for (;;) {
                __syncthreads();
                TrTile<64>::to_lds(d, scr, wave, lane, v);
                __syncthreads();
                const int nxt = it + G; const bool more = nxt < I0;
                TrDesc dn = d;
                if (more) { dn.k0 = (nxt / NBLK_N) * 64; dn.n0 = (nxt % NBLK_N) << 8; TrTile<64>::load(dn, wave, lane, v); }
                TrTile<64>::store(d, scr, wave, lane);
                if (!more) break;
                d = dn; it = nxt;
            }
        }
    }
    bf16_t* hb = (bf16_t*)(ws + WS_HB);
    for (int m = gw; m < M; m += 2 * NGW) {
        const int m1 = (m + NGW < M) ? m + NGW : m;
        const f32x4* xr0 = (const f32x4*)(P.x + (size_t)m * D) + lane; const f32x4* xr1 = (const f32x4*)(P.x + (size_t)m1 * D) + lane;
        f32x4 v[8], w[8]; float s0 = 0.f, s1 = 0.f;
#pragma unroll
        for (int j = 0; j < 8; ++j) v[j] = __builtin_nontemporal_load(xr0 + 64 * j);
#pragma unroll
        for (int j = 0; j < 8; ++j) w[j] = __builtin_nontemporal_load(xr1 + 64 * j);
#pragma unroll
        for (int j = 0; j < 8; ++j) s0 += (v[j][0] * v[j][0] + v[j][1] * v[j][1]) + (v[j][2] * v[j][2] + v[j][3] * v[j][3]);
#pragma unroll
        for (int j = 0; j < 8; ++j) s1 += (w[j][0] * w[j][0] + w[j][1] * w[j][1]) + (w[j][2] * w[j][2] + w[j][3] * w[j][3]);
        const float r0 = __builtin_amdgcn_rsqf(wave_sum(s0) * (1.0f / D) + RMS_EPS), r1 = __builtin_amdgcn_rsqf(wave_sum(s1) * (1.0f / D) + RMS_EPS);
        u32x2* o0 = (u32x2*)(hb + (size_t)m * D) + lane; u32x2* o1 = (u32x2*)(hb + (size_t)m1 * D) + lane;
#pragma unroll
        for (int j = 0; j < 8; ++j) { u32x2 t; t.x = cvt_pk_bf16(v[j][0] * r0, v[j][1] * r0); t.y = cvt_pk_bf16(v[j][2] * r0, v[j][3] * r0); o0[64 * j] = t; }
#pragma unroll
        for (int j = 0; j < 8; ++j) { u32x2 t; t.x = cvt_pk_bf16(w[j][0] * r1, w[j][1] * r1); t.y = cvt_pk_bf16(w[j][2] * r1, w[j][3] * r1); o1[64 * j] = t; }
    }
    bf16_t* pb = (bf16_t*)(ws + WS_PB);
    for (int i = gw * 64 + lane; i < M * PLE / 8; i += NGW * 64) {
        const f32x4 a = *(const f32x4*)(P.p + (size_t)i * 8), b = *(const f32x4*)(P.p + (size_t)i * 8 + 4);
        u32x4 w; w.x = cvt_pk_bf16(a[0], a[1]); w.y = cvt_pk_bf16(a[2], a[3]); w.z = cvt_pk_bf16(b[0], b[1]); w.w = cvt_pk_bf16(b[2], b[3]);
        *(u32x4*)(pb + (size_t)i * 8) = w;
    }
}

constexpr int P2_VPITCH = 272;
constexpr int P2_RED_OFF = 256 * P2_VPITCH;
__device__ __forceinline__ void unpack8(const u32x4 w, float (&f)[8]) {
    f[0] = bf_lo(w.x); f[1] = bf_hi(w.x); f[2] = bf_lo(w.y); f[3] = bf_hi(w.y); f[4] = bf_lo(w.z); f[5] = bf_hi(w.z); f[6] = bf_lo(w.w); f[7] = bf_hi(w.w);
}
__device__ __forceinline__ u32x4 pack8(const float (&f)[8]) { u32x4 w; w.x = cvt_pk_bf16(f[0], f[1]); w.y = cvt_pk_bf16(f[2], f[3]); w.z = cvt_pk_bf16(f[4], f[5]); w.w = cvt_pk_bf16(f[6], f[7]); return w; }
__device__ __forceinline__ float sum16(float s) { s += __shfl_xor(s, 1); s += __shfl_xor(s, 2); s += __shfl_xor(s, 4); s += __shfl_xor(s, 8); return s; }

__device__ __forceinline__ void p2_unit(const Ptrs& P, LAS unsigned char* lds, int item, int tid, bf16_t* qdst, bf16_t* kdst, bf16_t* cbdst) {
    unsigned char* ws = P.ws;
    const int b = item >> 7, n = (item >> 3) & 15, h = item & 7;
    const int cch = tid & 15, rg = tid >> 4, lane = tid & 63, wave = tid >> 6;
    const int c0 = h * 128 + cch * 8;
    bf16_t* qb = (bf16_t*)(ws + WS_Q); bf16_t* kb = (bf16_t*)(ws + WS_K); const bf16_t* vb = (const bf16_t*)(ws + WS_V);
    bf16_t* cb = (bf16_t*)(ws + WS_CB); const bf16_t* cc = (const bf16_t*)(ws + WS_CC); const bf16_t* cx = (const bf16_t*)(ws + WS_CX);
    float gq[8], gk[8], w0[8], w1[8], w2[8], ksum[8];
#pragma unroll
    for (int j = 0; j < 8; ++j) { gq[j] = P.g_q[cch * 8 + j] * QSCALE; gk[j] = P.g_k[cch * 8 + j]; w0[j] = P.w_conv[c0 + j]; w1[j] = P.w_conv[CW + c0 + j]; w2[j] = P.w_conv[2 * CW + c0 + j]; ksum[j] = 0.f; }
#pragma unroll 1
    for (int i = 0; i < 8; ++i) {
        const int rl = rg + 32 * i, t = n * 256 + rl; const size_t off = (size_t)(b * SEQ + t) * 1024 + c0;
        float f[8];
        {
            unpack8(*(const u32x4*)(qb + off), f); float s = 0.f;
#pragma unroll
            for (int j = 0; j < 8; ++j) s += f[j] * f[j];
            const float rs = __builtin_amdgcn_rsqf(sum16(s) * (1.0f / HD) + RMS_EPS);
#pragma unroll
            for (int j = 0; j < 8; ++j) f[j] = f[j] * rs * gq[j];
            *(u32x4*)(qdst + off) = pack8(f);
        }
        {
            unpack8(*(const u32x4*)(kb + off), f); float s = 0.f;
#pragma unroll
            for (int j = 0; j < 8; ++j) s += f[j] * f[j];
            const float rs = __builtin_amdgcn_rsqf(sum16(s) * (1.0f / HD) + RMS_EPS);
#pragma unroll
            for (int j = 0; j < 8; ++j) { f[j] = f[j] * rs * gk[j]; ksum[j] += f[j]; }
            *(u32x4*)(kdst + off) = pack8(f);
        }
        *(LAS u32x4*)(lds + rl * P2_VPITCH + cch * 16) = *(const u32x4*)(vb + off);
        {
            float a[8], c[8], y[8];
            unpack8(*(const u32x4*)(cc + off), a); unpack8(*(const u32x4*)(cx + off), c);
#pragma unroll
            for (int j = 0; j < 8; ++j) y[j] = w2[j] * (a[j] * c[j]);
            if (t >= 1) { unpack8(*(const u32x4*)(cc + off - 1024), a); unpack8(*(const u32x4*)(cx + off - 1024), c);
#pragma unroll
                for (int j = 0; j < 8; ++j) y[j] += w1[j] * (a[j] * c[j]); }
            if (t >= 2) { unpack8(*(const u32x4*)(cc + off - 2048), a); unpack8(*(const u32x4*)(cx + off - 2048), c);
#pragma unroll
                for (int j = 0; j < 8; ++j) y[j] += w0[j] * (a[j] * c[j]); }
            unpack8(*(const u32x4*)(cb + off), a);
#pragma unroll
            for (int j = 0; j < 8; ++j) y[j] *= a[j];
            *(u32x4*)(cbdst + off) = pack8(y);
        }
    }
    LAS float* red = (LAS float*)(lds + P2_RED_OFF);
#pragma unroll
    for (int j = 0; j < 8; ++j) { float s = ksum[j]; s += __shfl_xor(s, 16); s += __shfl_xor(s, 32); if (lane < 16) red[wave * 128 + cch * 8 + j] = s; }
    __syncthreads();
    if (tid < 128) { float s = 0.f;
#pragma unroll
        for (int w = 0; w < 8; ++w) s += red[w * 128 + tid];
        ((float*)(ws + WS_KMEAN))[((size_t)((b * NH + h) * NBLK + n)) * 128 + tid] = s * (1.0f / MOBA_BLK); }
    bf16_t* vt = (bf16_t*)(ws + WS_VT) + (size_t)((b * NH + h) * 64 + n * 4) * (128 * 64);
#pragma unroll 2
    for (int i = 0; i < 8; ++i) {
        const int ch = tid + 512 * i, d = ch & 127, kc = ch >> 7;
        const int kbase = (kc >> 1) * 16 + 4 * (kc & 1);
        unsigned short e[8];
#pragma unroll
        for (int j = 0; j < 8; ++j) e[j] = *(const LAS unsigned short*)(lds + (kbase + 8 * (j >> 2) + (j & 3)) * P2_VPITCH + d * 2);
        u32x4 w; w.x = e[0] | ((unsigned)e[1] << 16); w.y = e[2] | ((unsigned)e[3] << 16); w.z = e[4] | ((unsigned)e[5] << 16); w.w = e[6] | ((unsigned)e[7] << 16);
        const int kt = kc >> 3, slot0 = (kc & 7) * 8;
        *(u32x4*)(vt + (size_t)(kt * 128 + d) * 64 + slot0) = w;
    }
    __syncthreads();
}

constexpr int AT_KBUF = 128 * 256, AT_VBUF = 2 * 128 * 128;
constexpr int AT_STAGE = AT_KBUF + AT_VBUF;
#define MFMA32(a, b, c) __builtin_amdgcn_mfma_f32_32x32x16_bf16((a), (b), (c), 0, 0, 0)

__device__ __forceinline__ void attn_unit(const Ptrs& P, LAS unsigned char* lds, int bh, int qb, int half, int tid, bf16_t* Obuf) {
    unsigned char* ws = P.ws;
    const int b = bh >> 3, h = bh & 7;
    const int lane = tid & 63, r32 = lane & 31, hi = lane >> 5, wid = __builtin_amdgcn_readfirstlane(tid >> 6), wq = wid & 3, wk = wid >> 2;
    const bf16_t* Qn = (const bf16_t*)(ws + WS_Q); const bf16_t* Kn = (const bf16_t*)(ws + WS_K);
    const bf16_t* Vt = (const bf16_t*)(ws + WS_VT) + (size_t)bh * 64 * (128 * 64);
    const float* Kmean = (const float*)(ws + WS_KMEAN) + (size_t)bh * NBLK * 128;
    const size_t rowbase = (size_t)b * SEQ;
    const int qi = half * 128 + wq * 32 + r32;
    const size_t qrow = rowbase + qb * 256 + qi;

    const char* ksrc[4]; const char* vsrc[4];
#pragma unroll
    for (int i_ = 0; i_ < 4; ++i_) {
        const int pk = wid + 8 * i_, key = pk * 4 + (lane >> 4), ck = (lane & 15) ^ (key & 15);
        ksrc[i_] = (const char*)(Kn + (rowbase + key) * 1024 + h * 128 + ck * 8);
        const int pv = wid + 8 * i_, rr = pv * 8 + (lane >> 3), cv = (lane & 7) ^ ((rr >> 1) & 7);
        vsrc[i_] = (const char*)(Vt + (size_t)rr * 64 + cv * 8);
    }
#define AT_LOAD(it, buf) do { _Pragma("unroll") for (int i_ = 0; i_ < 4; ++i_) { \
        __builtin_amdgcn_global_load_lds((const unsigned*)(ksrc[i_] + (size_t)(it) * (128 * 1024 * 2)), (LAS unsigned*)(lds + (buf) * AT_STAGE + (wid + 8 * i_) * 1024), 16, 0, 0); \
        __builtin_amdgcn_global_load_lds((const unsigned*)(vsrc[i_] + (size_t)(it) * (2 * 128 * 64 * 2)), (LAS unsigned*)(lds + (buf) * AT_STAGE + AT_KBUF + (wid + 8 * i_) * 1024), 16, 0, 0); } } while (0)
#define AT_PUBLISH() do { asm volatile("s_waitcnt vmcnt(0)" ::: "memory"); __syncthreads(); } while (0)
    AT_LOAD(0, 0);

    bf16x8 qf[8];
#pragma unroll
    for (int d0 = 0; d0 < 8; ++d0) qf[d0] = *(const bf16x8*)(Qn + qrow * 1024 + h * 128 + d0 * 16 + hi * 8);

    float mref;
    { const float a = fabsf(P.g_q[lane] * P.g_k[lane]), c = fabsf(P.g_q[lane + 64] * P.g_k[lane + 64]); mref = wave_max(fmaxf(a, c)) * (11.313708498984761f * LOG2E); }

    unsigned selmask = 0u;
    {
        f32x16 g;
#pragma unroll
        for (int r = 0; r < 16; ++r) g[r] = 0.f;
#pragma unroll
        for (int d0 = 0; d0 < 8; ++d0) {
            u32x4 a = (u32x4){0u, 0u, 0u, 0u};
            if (r32 < 16) { const f32x4 x0 = *(const f32x4*)(Kmean + r32 * 128 + d0 * 16 + hi * 8), x1 = *(const f32x4*)(Kmean + r32 * 128 + d0 * 16 + hi * 8 + 4);
                a.x = cvt_pk_bf16(x0[0], x0[1]); a.y = cvt_pk_bf16(x0[2], x0[3]); a.z = cvt_pk_bf16(x1[0], x1[1]); a.w = cvt_pk_bf16(x1[2], x1[3]); }
            g = MFMA32(__builtin_bit_cast(bf16x8, a), qf[d0], g);
        }
        float gate[16];
#pragma unroll
        for (int r = 0; r < 8; ++r) { const float mine = g[r], other = __shfl_xor(mine, 32); const int bl = (r & 3) + 8 * (r >> 2);
            gate[bl] = hi == 0 ? mine : other; gate[bl + 4] = hi == 0 ? other : mine; }
#pragma unroll
        for (int pass = 0; pass < TOPK; ++pass) { float best = -INFINITY; int bi = -1;
#pragma unroll
            for (int nb = 0; nb < 16; ++nb) { const bool ok = (nb < qb) && !((selmask >> nb) & 1u) && (gate[nb] > best); best = ok ? gate[nb] : best; bi = ok ? nb : bi; }
            if (bi >= 0) selmask |= 1u << bi; }
    }

    f32x16 o[4];
#pragma unroll
    for (int dt = 0; dt < 4; ++dt)
#pragma unroll
        for (int r = 0; r < 16; ++r) o[dt][r] = 0.f;
    float lsum = 0.f;

    AT_PUBLISH();
    const int NIT = 2 * qb + 1 + half;
#pragma unroll 1
    for (int it = 0; it < NIT; ++it) {
        const int cur = it & 1, n = it >> 1, kt = 2 * (it & 1) + wk;
        if (it + 1 < NIT) AT_LOAD(it + 1, cur ^ 1);
        const bool diag = (n == qb);
        const bool lane_on = diag || ((selmask >> n) & 1u);
        const LAS unsigned char* kbuf = lds + cur * AT_STAGE + (wk * 64 + r32) * 256 + ((hi ^ (r32 & 1)) << 4);
        const LAS unsigned char* vbuf = lds + cur * AT_STAGE + AT_KBUF + (wk * 128 + r32) * 128 + ((hi ^ ((r32 >> 1) & 1)) << 4);
        const int kxs = (r32 >> 1) & 7, vxs = (r32 >> 2) & 3;
        const float cinit = lane_on ? -mref : -1.0e30f;
        if (diag || __any(lane_on)) {
#pragma unroll
            for (int kh = 0; kh < 2; ++kh) {
                if (diag && (2 * kt + kh > half * 4 + wq)) continue;
                f32x16 s;
#pragma unroll
                for (int r = 0; r < 16; ++r) s[r] = cinit;
#pragma unroll
                for (int d0 = 0; d0 < 8; ++d0) { const bf16x8 a = *(const LAS bf16x8*)(kbuf + kh * 32 * 256 + ((d0 ^ kxs) << 5)); s = MFMA32(a, qf[d0], s); }
                if (diag) {
                    const int kbase = 64 * kt + 32 * kh + 4 * hi;
#pragma unroll
                    for (int r = 0; r < 16; ++r) { const int kidx = kbase + (r & 3) + 8 * (r >> 2); const float p = __builtin_amdgcn_exp2f(s[r]); s[r] = (kidx <= qi) ? p : 0.f; lsum += s[r]; }
                } else {
#pragma unroll
                    for (int r = 0; r < 16; ++r) { s[r] = __builtin_amdgcn_exp2f(s[r]); lsum += s[r]; }
                }
#pragma unroll
                for (int sg = 0; sg < 2; ++sg) {
                    u32x4 pw; pw.x = cvt_pk_bf16(s[8 * sg + 0], s[8 * sg + 1]); pw.y = cvt_pk_bf16(s[8 * sg + 2], s[8 * sg + 3]); pw.z = cvt_pk_bf16(s[8 * sg + 4], s[8 * sg + 5]); pw.w = cvt_pk_bf16(s[8 * sg + 6], s[8 * sg + 7]);
                    const bf16x8 pf = __builtin_bit_cast(bf16x8, pw);
#pragma unroll
                    for (int dt = 0; dt < 4; ++dt) { const bf16x8 a = *(const LAS bf16x8*)(vbuf + dt * 32 * 128 + (((kh * 2 + sg) ^ vxs) << 5)); o[dt] = MFMA32(a, pf, o[dt]); }
                }
            }
        }
        AT_PUBLISH();
    }
    lsum += __shfl_xor(lsum, 32);
    LAS float* xch = (LAS float*)lds + (size_t)(wq * 64 + lane) * 65;
    if (wk == 1) {
#pragma unroll
        for (int dt = 0; dt < 4; ++dt)
#pragma unroll
            for (int r = 0; r < 16; ++r) xch[dt * 16 + r] = o[dt][r];
        xch[64] = lsum;
    }
    __syncthreads();
    if (wk == 0) {
#pragma unroll
        for (int dt = 0; dt < 4; ++dt)
#pragma unroll
            for (int r = 0; r < 16; ++r) o[dt][r] += xch[dt * 16 + r];
        lsum += xch[64];
        const float rl = __builtin_amdgcn_rcpf(lsum);
        bf16_t* orow = Obuf + qrow * 1024 + h * 128;
#pragma unroll
        for (int dt = 0; dt < 4; ++dt)
#pragma unroll
            for (int gq = 0; gq < 4; ++gq) { u32x2 w; w.x = cvt_pk_bf16(o[dt][4 * gq] * rl, o[dt][4 * gq + 1] * rl); w.y = cvt_pk_bf16(o[dt][4 * gq + 2] * rl, o[dt][4 * gq + 3] * rl);
                *(u32x2*)(orow + dt * 32 + 8 * gq + 4 * hi) = w; }
    }
    __syncthreads();
#undef AT_LOAD
#undef AT_PUBLISH
}


#define XB_TMO      128
#define XB_XCNT(j)  (256  + 64 * (j))
#define XB_XSUB(j)  (1280 + 64 * (j))
#define XB_XGEN(j)  (2304 + 64 * (j))
#define XB_TOP      3328
#define XB_TOPGEN   3392
#define XCD_BAR_WORDS 3456
#define XB_SPIN_CAP (1u << 18)
__device__ __forceinline__ unsigned xb_ld(unsigned* p)              { return __hip_atomic_load(p, __ATOMIC_RELAXED, __HIP_MEMORY_SCOPE_AGENT); }
__device__ __forceinline__ unsigned xb_add(unsigned* p, unsigned v) { return __hip_atomic_fetch_add(p, v, __ATOMIC_RELAXED, __HIP_MEMORY_SCOPE_AGENT); }
__device__ __forceinline__ unsigned xb_xcc_id() { return (unsigned)__builtin_amdgcn_s_getreg((3 << 11) | 20) & 0xFu; }
#define XB_SPIN(cond, bar) do { unsigned _sp = 0; while (cond) { __builtin_amdgcn_s_sleep(1); \
    if ((++_sp & 255u) == 0u) { if (xb_ld(&(bar)[XB_TMO])) break; if (_sp > XB_SPIN_CAP) { atomicAdd(&(bar)[XB_TMO], 1u); break; } } } } while (0)
struct XcdBarrier { unsigned* bar; unsigned x; volatile LAS unsigned* st; };
__device__ __forceinline__ XcdBarrier xcd_barrier_post(unsigned* bar, volatile LAS unsigned* st, int tid) {
    XcdBarrier b; b.bar = bar; b.x = xb_xcc_id(); b.st = st;
    if (tid == 0) (void)xb_add(&bar[XB_XCNT(b.x)], 1u);
    return b;
}
__device__ __forceinline__ void xcd_barrier_complete(unsigned* bar, unsigned x, unsigned& nloc, unsigned& nx) {
    const unsigned G = gridDim.x * gridDim.y * gridDim.z;
    unsigned sum, cnt, mine, sp = 0u;
    for (;;) {
        sum = 0u; cnt = 0u; mine = 0u;
#pragma unroll
        for (unsigned j = 0; j < 16; ++j) { const unsigned c = xb_ld(&bar[XB_XCNT(j)]); sum += c; cnt += (c > 0u) ? 1u : 0u; mine = (j == x) ? c : mine; }
        if (sum == G) break;
        __builtin_amdgcn_s_sleep(1);
        if ((++sp & 255u) == 0u) { if (xb_ld(&bar[XB_TMO])) break; if (sp > XB_SPIN_CAP) { atomicAdd(&bar[XB_TMO], 1u); break; } }
    }
    nloc = mine > 0u ? mine : 1u; nx = cnt > 0u ? cnt : 1u;
}
__device__ __forceinline__ void xcd_barrier(const XcdBarrier& b, const int wv) {
    asm volatile("s_waitcnt vmcnt(0)" ::: "memory");
    __syncthreads();
    if (wv == 0 && lane_id_asm() == 0) {
        unsigned* bar = b.bar;
        __builtin_amdgcn_s_waitcnt(0);
        unsigned nloc = b.st[0], nx = b.st[1];
        if (nloc == 0u) { xcd_barrier_complete(bar, b.x, nloc, nx); b.st[0] = nloc; b.st[1] = nx; }
        const unsigned old = xb_add(&bar[XB_XSUB(b.x)], 1u);
        const unsigned gen = old / nloc;
        if (old + 1u == (gen + 1u) * nloc) {
            __builtin_amdgcn_fence(__ATOMIC_RELEASE, "agent");
            asm volatile("s_waitcnt vmcnt(0)" ::: "memory");
            const unsigned og = xb_add(&bar[XB_TOP], 1u);
            const unsigned tg = og / nx;
            if (og + 1u == (tg + 1u) * nx) xb_add(&bar[XB_TOPGEN], 1u);
            else XB_SPIN(xb_ld(&bar[XB_TOPGEN]) == tg, bar);
            __builtin_amdgcn_fence(__ATOMIC_ACQUIRE, "agent");
            xb_add(&bar[XB_XGEN(b.x)], 1u);
            asm volatile("s_waitcnt vmcnt(0)" ::: "memory");
        } else {
            XB_SPIN(xb_ld(&bar[XB_XGEN(b.x)]) == gen, bar);
            __builtin_amdgcn_fence(__ATOMIC_ACQUIRE, "agent");
            asm volatile("s_waitcnt vmcnt(0)" ::: "memory");
        }
    }
    __syncthreads();
}

constexpr int NPHASES = 9;
struct Args { const float* in[16]; float* out; unsigned char* ws; int ph_lo, ph_hi; };
#ifndef PROBE_DUP
#define PROBE_DUP -1
#endif
#ifndef MK_N_LAUNCHES
#define MK_N_LAUNCHES 1
#endif

__global__ void __launch_bounds__(NTHREADS, 2) hybrid_fwd(Args args) {
    extern __shared__ __attribute__((aligned(16))) unsigned char lds_raw[];
    LAS unsigned char* lds = (LAS unsigned char*)lds_raw;
    cg::grid_group grid = cg::this_grid();
    volatile LAS unsigned* misc = (volatile LAS unsigned*)(lds + LDS_BYTES - 64);
    if (threadIdx.x < 16) misc[threadIdx.x] = 0u;
    __syncthreads();
    const int wv = __builtin_amdgcn_readfirstlane(threadIdx.x >> 6);
    XcdBarrier xbar = xcd_barrier_post((unsigned*)(args.ws + WS_CTL), misc, (int)threadIdx.x);
    if (args.ph_lo == -12345) grid.sync();
    const int G = gridDim.x, bx = blockIdx.x;
    const int vcu = (G % 8 == 0) ? (bx % 8) * (G / 8) + bx / 8 : bx;
    Ptrs P;
    P.x = args.in[0]; P.p = args.in[1]; P.g_mix = args.in[2]; P.w_in = args.in[3]; P.g_q = args.in[4]; P.g_k = args.in[5]; P.w_conv = args.in[6]; P.w_ao = args.in[7];
    P.w_co = args.in[8]; P.w_o = args.in[9]; P.g_mlp = args.in[10]; P.w_up = args.in[11]; P.w_dn = args.in[12]; P.g_ple = args.in[13]; P.w_g = args.in[14]; P.w_pp = args.in[15];
    P.out = args.out; P.ws = args.ws;
    unsigned char* ws = args.ws;
    const int lo = args.ph_lo, hi = args.ph_hi;
#define IN(k) (lo <= (k) && (k) < hi)
#define SEAM(k) do { if (IN(k) && IN((k) + 1)) { xcd_barrier(xbar, wv); if (PROBE_DUP == 9) { xcd_barrier(xbar, wv); xcd_barrier(xbar, wv); } } } while (0)
    using namespace pg8;

    if (IN(0)) { const int t0 = wv * 64 + lane_id_asm(); p0_prologue(P, lds, vcu, G, wv, t0 & 63);
        if (PROBE_DUP == 0) { __syncthreads(); p0_prologue(P, lds, vcu, G, wv, t0 & 63); } }
    SEAM(0);
    if (IN(1)) {
        Gemm g{(const bf16_t*)(ws + WS_HB), (const bf16_t*)(ws + WS_WIN), M, NZ, D}; StaticOrder S; S.init(M, NZ, G, bx);
        EpiZ E{ws};
        gemm_phase<EpiZ, StaticOrder, true, true>(lds, g, S, E, wv);
        if (PROBE_DUP == 1) gemm_phase<EpiZ, StaticOrder, true, true>(lds, g, S, E, wv);
    }
    SEAM(1);
    if (IN(2)) { const int t2 = wv * 64 + lane_id_asm(); if (PROBE_DUP == 2) { for (int it = vcu; it < BATCH * NBLK * NH; it += G) p2_unit(P, lds, it, t2, (bf16_t*)(ws + WS_WIN), (bf16_t*)(ws + WS_WIN + 16 * MiB), (bf16_t*)(ws + WS_HB)); }
        for (int it = vcu; it < BATCH * NBLK * NH; it += G) p2_unit(P, lds, it, t2, (bf16_t*)(ws + WS_Q), (bf16_t*)(ws + WS_K), (bf16_t*)(ws + WS_CB)); }
    SEAM(2);
    if (IN(3)) { const int t3 = wv * 64 + lane_id_asm(); for (int rep3 = (PROBE_DUP == 3 ? 0 : 1); rep3 < 2; ++rep3) { bf16_t* Ob = (bf16_t*)(ws + (rep3 ? WS_Q : WS_CC));
            for (int u = vcu; u < BATCH * NH * NBLK; u += G) { const int bh = u >> 4, j = u & 15;
#pragma unroll 1
                for (int k = 0; k < 2; ++k) attn_unit(P, lds, bh, k ? j : 15 - j, k ? 0 : 1, t3, Ob); } }
        late_weight_steal(P, lds, (unsigned*)(ws + WS_CTL) + XCD_BAR_WORDS + 64, wv, t3 & 63);
        if (PROBE_DUP == 33) late_weight_steal(P, lds, (unsigned*)(ws + WS_CTL) + XCD_BAR_WORDS + 128, wv, t3 & 63); }
    SEAM(3);
    for (int rep4 = 0; rep4 < (PROBE_DUP == 4 ? 2 : 1); ++rep4)
    if (IN(4)) {
        { Gemm g{(const bf16_t*)(ws + WS_CB), (const bf16_t*)(ws + WS_WCO), M, D, CW}; StaticOrder S; S.init(M, D, G, bx);
          EpiConvPart E{(const bf16_t*)(ws + WS_SC), (bf16_t*)(ws + WS_T1)};
          gemm_phase<EpiConvPart, StaticOrder, true, true>(lds, g, S, E, wv); }
        { Gemm g{(const bf16_t*)(ws + WS_Q), (const bf16_t*)(ws + WS_WAO), M, D, AW}; StaticOrder S; S.init(M, D, G, bx);
          EpiMerged E{(const bf16_t*)(ws + WS_SA), (const bf16_t*)(ws + WS_T1), (bf16_t*)(ws + WS_MERGED)};
          gemm_phase<EpiMerged, StaticOrder, true, true>(lds, g, S, E, wv); }
    }
    SEAM(4);
    if (IN(5)) {
        Gemm g{(const bf16_t*)(ws + WS_MERGED), (const bf16_t*)(ws + WS_WO), M, D, D}; StaticOrder S; S.init(M, D, G, bx);
        EpiResid<false> E{P.x, (bf16_t*)(ws + WS_R1B), (float*)(ws + WS_ST1)};
        gemm_phase<EpiResid<false>, StaticOrder, false, true>(lds, g, S, E, wv);
    }
    SEAM(5);
    if (IN(6)) {
        Gemm g{(const bf16_t*)(ws + WS_R1B), (const bf16_t*)(ws + WS_WUP), M, FF, D}; StaticOrder S; S.init(M, FF, G, bx);
        EpiUp E{(const float*)(ws + WS_ST1), (bf16_t*)(ws + WS_ACT)};
        gemm_phase<EpiUp, StaticOrder, true, true>(lds, g, S, E, wv);
        if (PROBE_DUP == 6) gemm_phase<EpiUp, StaticOrder, true, true>(lds, g, S, E, wv);
    }
    SEAM(6);
    if (IN(7)) {
        Gemm g{(const bf16_t*)(ws + WS_ACT), (const bf16_t*)(ws + WS_WDN), M, D, FF}; StaticOrder S; S.init(M, D, G, bx);
        EpiResid<true> E{(const bf16_t*)(ws + WS_R1B), (bf16_t*)(ws + WS_R2B), (float*)(ws + WS_ST2)};
        gemm_phase<EpiResid<true>, StaticOrder, false, true>(lds, g, S, E, wv);
    }
    SEAM(7);
    if (IN(8)) {
        { Gemm g{(const bf16_t*)(ws + WS_PB), (const bf16_t*)(ws + WS_WPP), M, D, PLE}; StaticOrder S; S.init(M, D, G, bx);
          EpiStoreBf16 E{(bf16_t*)(ws + WS_T2)};
          gemm_phase<EpiStoreBf16, StaticOrder, true, true>(lds, g, S, E, wv); }
        { Gemm g{(const bf16_t*)(ws + WS_R2B), (const bf16_t*)(ws + WS_WG), M, D, D}; StaticOrder S; S.init(M, D, G, bx);
          EpiOut E{(const float*)(ws + WS_ST2), (const bf16_t*)(ws + WS_T2), (const bf16_t*)(ws + WS_R2B), P.out};
          gemm_phase<EpiOut, StaticOrder, true, true>(lds, g, S, E, wv); }
    }
#undef IN
#undef SEAM
}

extern "C" void kernel_launch(void* const* d_in, const int* in_sizes, int n_in, void* d_out, int out_size, void* d_ws, size_t ws_size, hipStream_t stream) {
    static int grid = 0;
    if (grid == 0) {
        if (n_in != 16 || in_sizes[0] != M * D || out_size != M * D || ws_size < WS_END) { fprintf(stderr, "kernel_launch: unexpected shapes (n_in %d, in0 %d, out %d, ws %zu); nothing launched\n", n_in, n_in > 0 ? in_sizes[0] : -1, out_size, ws_size); grid = -1; return; }
        int dev = 0, cus = 0, per_cu = 0;
        if (hipGetDevice(&dev) != hipSuccess || hipDeviceGetAttribute(&cus, hipDeviceAttributeMultiprocessorCount, dev) != hipSuccess) { fprintf(stderr, "kernel_launch: device query failed\n"); grid = -1; return; }
        if (hipFuncSetAttribute((const void*)hybrid_fwd, hipFuncAttributeMaxDynamicSharedMemorySize, LDS_BYTES) != hipSuccess) { fprintf(stderr, "kernel_launch: hipFuncSetAttribute failed\n"); grid = -1; return; }
        if (hipOccupancyMaxActiveBlocksPerMultiprocessor(&per_cu, (const void*)hybrid_fwd, NTHREADS, LDS_BYTES) != hipSuccess || per_cu < 1) { fprintf(stderr, "kernel_launch: occupancy query says %d blocks per CU\n", per_cu); per_cu = 1; }
        (void)hipGetLastError();
        grid = cus * 1;
    }
    if (grid < 0) return;
    if (hipMemsetAsync((char*)d_ws + WS_CTL, 0, CTL_ZERO_BYTES, stream) != hipSuccess) { fprintf(stderr, "kernel_launch: memset of the barrier words failed\n"); return; }
    Args a{};
    for (int i = 0; i < 16; ++i) a.in[i] = (const float*)d_in[i];
    a.out = (float*)d_out; a.ws = (unsigned char*)d_ws;
    constexpr int NL = MK_N_LAUNCHES;
    for (int li = 0; li < NL; ++li) {
        a.ph_lo = (NL == 1) ? 0 : li; a.ph_hi = (NL == 1) ? NPHASES : li + 1;
        void* kargs[] = {&a};
        const hipError_t e = hipLaunchCooperativeKernel((const void*)hybrid_fwd, dim3(grid), dim3(NTHREADS), kargs, LDS_BYTES, stream);
        if (e != hipSuccess) { fprintf(stderr, "kernel_launch: cooperative launch %d failed: %s (grid %d)\n", li, hipGetErrorString(e), grid); break; }
    }
}
```

```cpp
#include <hip/hip_runtime.h>
#include <hip/hip_cooperative_groups.h>
#include <cstdio>
#include <cstdint>
namespace cg = cooperative_groups;

#define LAS __attribute__((address_space(3)))
#define GAS __attribute__((address_space(1)))
typedef unsigned short bf16_t;
typedef short bf16x8 __attribute__((ext_vector_type(8)));
typedef float f32x4 __attribute__((ext_vector_type(4)));
typedef float f32x2 __attribute__((ext_vector_type(2)));
typedef float f32x16 __attribute__((ext_vector_type(16)));
typedef unsigned u32x4 __attribute__((ext_vector_type(4)));
typedef unsigned u32x2 __attribute__((ext_vector_type(2)));

constexpr int BATCH = 2, SEQ = 4096, M = BATCH * SEQ, D = 2048, NH = 8, HD = 128, AW = 1024, CW = 1024, FF = 8192, PLE = 256;
constexpr int NZ = 10240, MOBA_BLK = 256, NBLK = SEQ / MOBA_BLK, TOPK = 3;
constexpr float RMS_EPS = 1e-6f;
constexpr float LOG2E = 1.4426950408889634f;
constexpr float QSCALE = 0.08838834764831845f * LOG2E;
constexpr int NWAVES = 8, NTHREADS = 512;
constexpr int LDS_BYTES = 147456;

constexpr size_t MiB = 1u << 20;
constexpr size_t WS_Q = 0 * MiB, WS_K = 16 * MiB, WS_CB = 32 * MiB, WS_SA = 48 * MiB, WS_SC = 80 * MiB, WS_V = 112 * MiB, WS_CC = 128 * MiB, WS_CX = 144 * MiB;
constexpr size_t WS_HB = 160 * MiB;
constexpr size_t WS_VT = 176 * MiB;
constexpr size_t WS_T1 = 112 * MiB;
constexpr size_t WS_R1B = 160 * MiB;
constexpr size_t WS_ACT = 0 * MiB;
constexpr size_t WS_R2B = 128 * MiB;
constexpr size_t WS_T2 = 0 * MiB;
constexpr size_t WS_WIN = 192 * MiB, WS_WUP = 232 * MiB, WS_WDN = 264 * MiB, WS_WO = 296 * MiB, WS_WG = 304 * MiB, WS_WAO = 312 * MiB, WS_WCO = 316 * MiB, WS_WPP = 320 * MiB;
constexpr size_t WS_MERGED = 192 * MiB;
constexpr size_t WS_PB = 321 * MiB;
constexpr size_t WS_ST1 = 325 * MiB;
constexpr size_t WS_ST2 = WS_ST1 + 256 * 1024;
constexpr size_t WS_KMEAN = WS_ST2 + 256 * 1024;
constexpr size_t WS_CTL = 326 * MiB, CTL_ZERO_BYTES = 16384;
constexpr size_t WS_END = 327 * MiB;

__device__ __forceinline__ unsigned cvt_pk_bf16(float lo, float hi) { unsigned r; asm volatile("v_cvt_pk_bf16_f32 %0, %1, %2" : "=v"(r) : "v"(lo), "v"(hi)); return r; }
__device__ __forceinline__ int lane_id_asm() { int l; asm volatile("v_mbcnt_lo_u32_b32 %0, -1, 0\n\tv_mbcnt_hi_u32_b32 %0, -1, %0" : "=v"(l)); return l; }
__device__ __forceinline__ float bf_lo(unsigned u) { return __uint_as_float(u << 16); }
__device__ __forceinline__ float bf_hi(unsigned u) { return __uint_as_float(u & 0xffff0000u); }
__device__ __forceinline__ float sigmoidf_fast(float x) { return __builtin_amdgcn_rcpf(1.0f + __builtin_amdgcn_exp2f(-x * LOG2E)); }

namespace pg8 {
constexpr int BM = 256, BK = 64, HALF = 128, HTB = HALF * BK * 2  , STAGE_BYTES = 8 * HTB, NXCD = 8, WGM = 8;
__host__ __device__ __forceinline__ int lds_byte(int r, int c) { const int st = (r >> 4) * 2 + (c >> 5), rr = r & 15, cc = c & 31, ob = rr * 64 + cc * 2; return st * 1024 + (ob ^ (((ob >> 9) & 1) << 5)); }
__host__ __device__ __forceinline__ void stage_rc(int b, int& R, int& C) { const int st = b / 1024, sb = b % 1024, swz = sb ^ (((sb >> 9) & 1) << 5); R = (st >> 1) * 16 + swz / 64; C = (st & 1) * 32 + (swz % 64) / 2; }
__host__ __device__ __forceinline__ int perm32(int rho) { const int n = rho >> 4, i = rho & 15; return 8 * (i >> 2) + 4 * n + (i & 3); }

struct Unit { int pm, pn; };
struct Gemm { const bf16_t* A; const bf16_t* Bt; int M, N, K; };

struct StaticOrder {
    int nM, nN, nwg, G, c;
    __host__ __device__ void init(int M_, int N_, int G_, int c_) { nM = M_ / BM; nN = N_ / BM; nwg = nM * nN; G = G_; c = c_; }
    __host__ __device__ bool next(int i, Unit& u) const {
        const long L = (long)i * G + c; if (L >= nwg) return false;
        int wgid = (int)L; { const int q = nwg / NXCD, r = nwg % NXCD, xcd = wgid % NXCD, off = wgid / NXCD; wgid = (xcd < r ? xcd * (q + 1) : r * (q + 1) + (xcd - r) * q) + off; }
        const int nig = WGM * nN, gid = wgid / nig, fm = gid * WGM, gsz = (nM - fm) < WGM ? (nM - fm) : WGM;
        u.pm = fm + ((wgid % nig) % gsz); u.pn = (wgid % nig) / gsz; return true;
    }
    __device__ __forceinline__ void a_ready(const Unit&) const {}
    __device__ __forceinline__ void done(const Unit&) const {}
};

typedef f32x4 Acc[2][2][4][2];

struct EpiZ {
    static constexpr bool PERM = true, AFTER_DRAIN = false;
    unsigned char* ws;
    __device__ __forceinline__ void operator()(const Acc& acc, const Unit& u, int wr, int wc, int fr, int fq) const {
        const int pn = u.pn; const int seg = pn < 24 ? (pn >> 2) : (pn < 32 ? 6 : 7);
        const size_t boff = seg == 0 ? WS_Q : seg == 1 ? WS_K : seg == 2 ? WS_V : seg == 3 ? WS_CB : seg == 4 ? WS_CC : seg == 5 ? WS_CX : seg == 6 ? WS_SA : WS_SC;
        const int ldc = seg < 6 ? 1024 : 2048; const int colt = seg < 6 ? (pn & 3) * 256 : ((pn - 24) & 7) * 256; const bool sg = seg >= 6;
        bf16_t* base = (bf16_t*)(ws + boff);
        const int row0 = u.pm * BM + wr * 64 + fr, col0 = colt + wc * 32 + 8 * fq;
#pragma unroll
        for (int ai = 0; ai < 2; ++ai)
#pragma unroll
            for (int m = 0; m < 4; ++m) { bf16_t* rowp = base + (size_t)(row0 + ai * HALF + m * 16) * ldc + col0;
#pragma unroll
                for (int bj = 0; bj < 2; ++bj) { f32x4 v0 = acc[ai][bj][m][0], v1 = acc[ai][bj][m][1];
                    if (sg) {
#pragma unroll
                        for (int j = 0; j < 4; ++j) { v0[j] = sigmoidf_fast(v0[j]); v1[j] = sigmoidf_fast(v1[j]); } }
                    u32x4 w; w.x = cvt_pk_bf16(v0[0], v0[1]); w.y = cvt_pk_bf16(v0[2], v0[3]); w.z = cvt_pk_bf16(v1[0], v1[1]); w.w = cvt_pk_bf16(v1[2], v1[3]);
                    *(u32x4*)(rowp + bj * HALF) = w; } }
    }
};
struct EpiConvPart {
    static constexpr bool PERM = true, AFTER_DRAIN = false;
    const bf16_t* sc; bf16_t* t1;
    __device__ __forceinline__ void operator()(const Acc& acc, const Unit& u, int wr, int wc, int fr, int fq) const {
        const int row0 = u.pm * BM + wr * 64 + fr, col0 = u.pn * BM + wc * 32 + 8 * fq;
#pragma unroll
        for (int ai = 0; ai < 2; ++ai)
#pragma unroll
            for (int m = 0; m < 4; ++m) { const size_t off = (size_t)(row0 + ai * HALF + m * 16) * D + col0;
#pragma unroll
                for (int bj = 0; bj < 2; ++bj) { const u32x4 g = *(const u32x4*)(sc + off + bj * HALF);
                    f32x4 v0 = acc[ai][bj][m][0], v1 = acc[ai][bj][m][1];
                    v0[0] *= bf_lo(g.x); v0[1] *= bf_hi(g.x); v0[2] *= bf_lo(g.y); v0[3] *= bf_hi(g.y); v1[0] *= bf_lo(g.z); v1[1] *= bf_hi(g.z); v1[2] *= bf_lo(g.w); v1[3] *= bf_hi(g.w);
                    u32x4 w; w.x = cvt_pk_bf16(v0[0], v0[1]); w.y = cvt_pk_bf16(v0[2], v0[3]); w.z = cvt_pk_bf16(v1[0], v1[1]); w.w = cvt_pk_bf16(v1[2], v1[3]);
                    *(u32x4*)(t1 + off + bj * HALF) = w; }
                if (m & 1) asm volatile("" ::: "memory"); }
    }
};
struct EpiMerged {
    static constexpr bool PERM = true, AFTER_DRAIN = false;
    const bf16_t* sa; const bf16_t* t1; bf16_t* out;
    __device__ __forceinline__ void operator()(const Acc& acc, const Unit& u, int wr, int wc, int fr, int fq) const {
        const int row0 = u.pm * BM + wr * 64 + fr, col0 = u.pn * BM + wc * 32 + 8 * fq;
#pragma unroll
        for (int ai = 0; ai < 2; ++ai)
#pragma unroll
            for (int m = 0; m < 4; ++m) { const size_t off = (size_t)(row0 + ai * HALF + m * 16) * D + col0;
#pragma unroll
                for (int bj = 0; bj < 2; ++bj) { const u32x4 g = *(const u32x4*)(sa + off + bj * HALF);
                    const u32x4 tw = *(const u32x4*)(t1 + off + bj * HALF); const f32x4 a0 = (f32x4){bf_lo(tw.x), bf_hi(tw.x), bf_lo(tw.y), bf_hi(tw.y)}, a1 = (f32x4){bf_lo(tw.z), bf_hi(tw.z), bf_lo(tw.w), bf_hi(tw.w)};
                    f32x4 v0 = acc[ai][bj][m][0], v1 = acc[ai][bj][m][1];
                    v0[0] = v0[0] * bf_lo(g.x) + a0[0]; v0[1] = v0[1] * bf_hi(g.x) + a0[1]; v0[2] = v0[2] * bf_lo(g.y) + a0[2]; v0[3] = v0[3] * bf_hi(g.y) + a0[3];
                    v1[0] = v1[0] * bf_lo(g.z) + a1[0]; v1[1] = v1[1] * bf_hi(g.z) + a1[1]; v1[2] = v1[2] * bf_lo(g.w) + a1[2]; v1[3] = v1[3] * bf_hi(g.w) + a1[3];
                    u32x4 w; w.x = cvt_pk_bf16(v0[0], v0[1]); w.y = cvt_pk_bf16(v0[2], v0[3]); w.z = cvt_pk_bf16(v1[0], v1[1]); w.w = cvt_pk_bf16(v1[2], v1[3]);
                    *(u32x4*)(out + off + bj * HALF) = w; }
                if (m & 1) asm volatile("" ::: "memory"); }
    }
};
template <bool BASE_BF16> struct EpiResid {
    static constexpr bool PERM = false, AFTER_DRAIN = true;
    const void* base; bf16_t* rb; float* stats;
    __device__ __forceinline__ void fused(Acc& acc, const Unit& u, int wr, int wc, int fr, int fq, LAS unsigned char* lds, int wid, int lane) const {
        LAS float* P = (LAS float*)lds;
        const int col0 = u.pn * BM + wc * 32 + 4 * fq;
#pragma unroll
        for (int ai = 0; ai < 2; ++ai)
#pragma unroll
            for (int m = 0; m < 4; ++m) { const int rl = ai * HALF + wr * 64 + m * 16 + fr; const size_t off = (size_t)(u.pm * BM + rl) * D + col0; float s = 0.f;
#pragma unroll
                for (int bj = 0; bj < 2; ++bj)
#pragma unroll
                    for (int n = 0; n < 2; ++n) { f32x4 b;
                        if (BASE_BF16) { const u32x2 bw = *(const u32x2*)((const bf16_t*)base + off + bj * HALF + n * 16); b = (f32x4){bf_lo(bw.x), bf_hi(bw.x), bf_lo(bw.y), bf_hi(bw.y)}; }
                        else b = *(const f32x4*)((const float*)base + off + bj * HALF + n * 16);
                        const f32x4 v = acc[ai][bj][m][n] + b;
                        u32x2 w; w.x = cvt_pk_bf16(v[0], v[1]); w.y = cvt_pk_bf16(v[2], v[3]); *(u32x2*)(rb + off + bj * HALF + n * 16) = w;
                        s += (v[0] * v[0] + v[1] * v[1]) + (v[2] * v[2] + v[3] * v[3]); }
                s += __shfl_xor(s, 16); s += __shfl_xor(s, 32);
                if (fq == 0) P[rl * 4 + wc] = s;
                asm volatile("" ::: "memory"); }
        __syncthreads();
        const int t = wid * 64 + lane;
        if (t < 256) { const float s = (P[t * 4 + 0] + P[t * 4 + 1]) + (P[t * 4 + 2] + P[t * 4 + 3]); stats[(size_t)(u.pm * BM + t) * 8 + u.pn] = s; }
        __syncthreads();
    }
};
__device__ __forceinline__ float row_rstd(const float* stats, int row) {
    const f32x4 a = *(const f32x4*)(stats + (size_t)row * 8), b = *(const f32x4*)(stats + (size_t)row * 8 + 4);
    const float s = ((a[0] + a[1]) + (a[2] + a[3])) + ((b[0] + b[1]) + (b[2] + b[3]));
    return __builtin_amdgcn_rsqf(s * (1.0f / D) + RMS_EPS);
}
struct EpiUp {
    static constexpr bool PERM = true, AFTER_DRAIN = false;
    const float* stats; bf16_t* out;
    __device__ __forceinline__ void operator()(const Acc& acc, const Unit& u, int wr, int wc, int fr, int fq) const {
        const int row0 = u.pm * BM + wr * 64 + fr, col0 = u.pn * BM + wc * 32 + 8 * fq;
#pragma unroll
        for (int ai = 0; ai < 2; ++ai)
#pragma unroll
            for (int m = 0; m < 4; ++m) { const int row = row0 + ai * HALF + m * 16; const float rs = row_rstd(stats, row); bf16_t* rowp = out + (size_t)row * FF + col0;
#pragma unroll
                for (int bj = 0; bj < 2; ++bj) { f32x4 v0 = acc[ai][bj][m][0] * rs, v1 = acc[ai][bj][m][1] * rs;
#pragma unroll
                    for (int j = 0; j < 4; ++j) { v0[j] = fmaxf(v0[j], 0.f); v0[j] *= v0[j]; v1[j] = fmaxf(v1[j], 0.f); v1[j] *= v1[j]; }
                    u32x4 w; w.x = cvt_pk_bf16(v0[0], v0[1]); w.y = cvt_pk_bf16(v0[2], v0[3]); w.z = cvt_pk_bf16(v1[0], v1[1]); w.w = cvt_pk_bf16(v1[2], v1[3]);
                    *(u32x4*)(rowp + bj * HALF) = w; } }
    }
};
struct EpiStoreBf16 {
    static constexpr bool PERM = false, AFTER_DRAIN = false;
    bf16_t* t2;
    __device__ __forceinline__ void operator()(const Acc& acc, const Unit& u, int wr, int wc, int fr, int fq) const {
        const int col0 = u.pn * BM + wc * 32 + 4 * fq;
#pragma unroll
        for (int ai = 0; ai < 2; ++ai)
#pragma unroll
            for (int m = 0; m < 4; ++m) { const size_t off = (size_t)(u.pm * BM + ai * HALF + wr * 64 + m * 16 + fr) * D + col0;
#pragma unroll
                for (int bj = 0; bj < 2; ++bj)
#pragma unroll
                    for (int n = 0; n < 2; ++n) { const f32x4 v = acc[ai][bj][m][n]; u32x2 w; w.x = cvt_pk_bf16(v[0], v[1]); w.y = cvt_pk_bf16(v[2], v[3]); *(u32x2*)(t2 + off + bj * HALF + n * 16) = w; } }
    }
};
struct EpiOut {
    static constexpr bool PERM = false, AFTER_DRAIN = false;
    const float* stats; const bf16_t* t2; const bf16_t* rin; float* out;
    __device__ __forceinline__ void operator()(const Acc& acc, const Unit& u, int wr, int wc, int fr, int fq) const {
        const int col0 = u.pn * BM + wc * 32 + 4 * fq;
#pragma unroll
        for (int ai = 0; ai < 2; ++ai)
#pragma unroll
            for (int m = 0; m < 4; ++m) { const int row = u.pm * BM + ai * HALF + wr * 64 + m * 16 + fr; const size_t off = (size_t)row * D + col0; const float rs = row_rstd(stats, row);
#pragma unroll
                for (int bj = 0; bj < 2; ++bj)
#pragma unroll
                    for (int n = 0; n < 2; ++n) { const u32x2 rw = *(const u32x2*)(rin + off + bj * HALF + n * 16), tw = *(const u32x2*)(t2 + off + bj * HALF + n * 16); const f32x4 r = (f32x4){bf_lo(rw.x), bf_hi(rw.x), bf_lo(rw.y), bf_hi(rw.y)}, t = (f32x4){bf_lo(tw.x), bf_hi(tw.x), bf_lo(tw.y), bf_hi(tw.y)}; f32x4 v = acc[ai][bj][m][n] * rs;
#pragma unroll
                        for (int j = 0; j < 4; ++j) v[j] = r[j] + sigmoidf_fast(v[j]) * t[j];
                        *(f32x4*)(out + off + bj * HALF + n * 16) = v; }
                if (m & 1) asm volatile("" ::: "memory"); }
    }
};

#define PG8_LAS LAS
template <class Epi, class Sched, bool ALIGN_EPI = false, bool SP2 = false>
__device__ __forceinline__ void gemm_phase(PG8_LAS unsigned char* lds, const Gemm g, const Sched& S, const Epi& E, const int wv) {
    const int tid_ = wv * 64 + lane_id_asm();
    const int tid = tid_, wid = wv, lane = tid & 63, wr = wid >> 2, wc = wid & 3, fr = lane & 15, fq = lane >> 4;
    const int K = g.K, nt = K / BK;
    unsigned voffA[2], voffB[2];
#pragma unroll
    for (int i = 0; i < 2; ++i) { int R, C; stage_rc(tid * 16 + i * 8192, R, C); const int Rb = Epi::PERM ? ((R & ~31) + perm32(R & 31)) : R;
        voffA[i] = (unsigned)(R * K + C) * 2u; voffB[i] = (unsigned)(Rb * K + C) * 2u; }
    const size_t kstep = (size_t)(BK * 2);
    const size_t hstep = (size_t)HALF * K * 2;
    const size_t tstep = 2 * hstep;
    const unsigned ldsw = (unsigned)wid * 1024u;
    const int aoff = lds_byte(wr * 64 + fr, fq * 8), boff = lds_byte(wc * 32 + fr, fq * 8);
#define PG8_SA(b, h) (((b) * 2 + (h)) * HTB)
#define PG8_SB(b, h) ((4 + (b) * 2 + (h)) * HTB)
#define PG8_STAGE(bufoff, gbase, voff) do { _Pragma("unroll") for (int _i = 0; _i < 2; ++_i) \
        __builtin_amdgcn_global_load_lds((const unsigned*)((const char*)(gbase) + (voff)[_i]), (PG8_LAS unsigned*)(lds + (bufoff) + ldsw + _i * 8192), 16, 0, 0); } while (0)
#define PG8_LDA(dst, b, h) do { _Pragma("unroll") for (int m = 0; m < 4; ++m) _Pragma("unroll") for (int k = 0; k < 2; ++k) dst[m][k] = *(const PG8_LAS bf16x8*)(lds + PG8_SA(b, h) + aoff + m * 2048 + k * 1024); } while (0)
#define PG8_LDB(dst, b, h) do { _Pragma("unroll") for (int n = 0; n < 2; ++n) _Pragma("unroll") for (int k = 0; k < 2; ++k) dst[n][k] = *(const PG8_LAS bf16x8*)(lds + PG8_SB(b, h) + boff + n * 2048 + k * 1024); } while (0)
#define PG8_MMA(ai, bj, At, Bt) do { __builtin_amdgcn_s_setprio(1); _Pragma("unroll") for (int m = 0; m < 4; ++m) _Pragma("unroll") for (int n = 0; n < 2; ++n) _Pragma("unroll") for (int k = 0; k < 2; ++k) \
        acc[ai][bj][m][n] = __builtin_amdgcn_mfma_f32_16x16x32_bf16(Bt[n][k], At[m][k], acc[ai][bj][m][n], 0, 0, 0); __builtin_amdgcn_s_setprio(0); } while (0)
#define PG8_WAIT_V(n) asm volatile("s_waitcnt vmcnt(" #n ")" ::: "memory")
#define PG8_WAIT_L(n) asm volatile("s_waitcnt lgkmcnt(" #n ")" ::: "memory")
#define PG8_BAR __builtin_amdgcn_s_barrier()
#define PG8_SCHED __builtin_amdgcn_sched_barrier(0)
    Unit cur, nxt; int ui = 0;
    if (!S.next(0, cur)) return;
    f32x4 acc[2][2][4][2];
#pragma unroll
    for (int a = 0; a < 2; ++a)
#pragma unroll
        for (int b = 0; b < 2; ++b)
#pragma unroll
            for (int m = 0; m < 4; ++m)
#pragma unroll
                for (int n = 0; n < 2; ++n) acc[a][b][m][n] = (f32x4){0.f, 0.f, 0.f, 0.f};
    bf16x8 At[4][2], B0[2][2], B1[2][2];
    const char* cA = (const char*)g.A + (size_t)cur.pm * tstep; const char* cB = (const char*)g.Bt + (size_t)cur.pn * tstep;
    S.a_ready(cur);
    if constexpr (SP2) {
        PG8_STAGE(PG8_SB(0, 0), cB, voffB); PG8_STAGE(PG8_SB(0, 1), cB + hstep, voffB); PG8_STAGE(PG8_SA(0, 0), cA, voffA); PG8_STAGE(PG8_SA(0, 1), cA + hstep, voffA);
        if (wr == 1) PG8_BAR;
        PG8_WAIT_V(2); PG8_BAR;
        PG8_STAGE(PG8_SB(1, 0), cB + kstep, voffB); PG8_STAGE(PG8_SA(1, 0), cA + kstep, voffA); PG8_STAGE(PG8_SB(1, 1), cB + hstep + kstep, voffB);
        PG8_WAIT_V(6); PG8_BAR;
    } else {
        PG8_STAGE(PG8_SB(0, 0), cB, voffB); PG8_STAGE(PG8_SA(0, 0), cA, voffA); PG8_STAGE(PG8_SB(0, 1), cB + hstep, voffB); PG8_STAGE(PG8_SA(0, 1), cA + hstep, voffA);
        if (wr == 1) PG8_BAR;
        PG8_WAIT_V(4); PG8_BAR;
        PG8_STAGE(PG8_SB(1, 0), cB + kstep, voffB); PG8_STAGE(PG8_SA(1, 0), cA + kstep, voffA); PG8_STAGE(PG8_SB(1, 1), cB + hstep + kstep, voffB);
        PG8_WAIT_V(6); PG8_BAR;
    }
    for (;;) {
        const bool has_next = S.next(ui + 1, nxt);
        const char* nA = has_next ? (const char*)g.A + (size_t)nxt.pm * tstep : cA; const char* nB = has_next ? (const char*)g.Bt + (size_t)nxt.pn * tstep : cB;
        for (int t = 0; t < nt; t += 2) {
            const bool last = (t == nt - 2);
            const char* a1 = cA + (size_t)(t + 1) * kstep;
            const char* a2 = last ? nA : cA + (size_t)(t + 2) * kstep; const char* b2 = last ? nB : cB + (size_t)(t + 2) * kstep;
            const char* a3 = a2 + kstep; const char* b3 = b2 + kstep;
            if (last && has_next) S.a_ready(nxt);
            if constexpr (SP2) {
            PG8_LDB(B0, 0, 0); PG8_LDB(B1, 0, 1); PG8_SCHED; PG8_LDA(At, 0, 0); PG8_STAGE(PG8_SA(1, 1), a1 + hstep, voffA);
            PG8_WAIT_V(8); PG8_WAIT_L(0); PG8_BAR; PG8_MMA(0, 0, At, B0); PG8_MMA(0, 1, At, B1); PG8_BAR; PG8_SCHED;
            PG8_LDA(At, 0, 1); PG8_STAGE(PG8_SB(0, 0), b2, voffB); PG8_STAGE(PG8_SB(0, 1), b2 + hstep, voffB); PG8_STAGE(PG8_SA(0, 0), a2, voffA);
            PG8_WAIT_V(8); PG8_WAIT_L(0); PG8_BAR; PG8_MMA(1, 0, At, B0); PG8_MMA(1, 1, At, B1); PG8_BAR; PG8_SCHED;
            PG8_LDB(B0, 1, 0); PG8_LDB(B1, 1, 1); PG8_SCHED; PG8_LDA(At, 1, 0); PG8_STAGE(PG8_SA(0, 1), a2 + hstep, voffA);
            PG8_WAIT_V(8); PG8_WAIT_L(0); PG8_BAR; PG8_MMA(0, 0, At, B0); PG8_MMA(0, 1, At, B1); PG8_BAR; PG8_SCHED;
            PG8_LDA(At, 1, 1); PG8_STAGE(PG8_SB(1, 0), b3, voffB); PG8_STAGE(PG8_SB(1, 1), b3 + hstep, voffB); PG8_STAGE(PG8_SA(1, 0), a3, voffA);
            PG8_WAIT_V(8); PG8_WAIT_L(0); PG8_BAR; PG8_MMA(1, 0, At, B0); PG8_MMA(1, 1, At, B1); PG8_BAR; PG8_SCHED;
            } else {
            PG8_LDB(B0, 0, 0); PG8_SCHED; PG8_LDA(At, 0, 0); PG8_STAGE(PG8_SA(1, 1), a1 + hstep, voffA);
            PG8_WAIT_L(8); PG8_BAR; PG8_WAIT_L(0); PG8_MMA(0, 0, At, B0); PG8_BAR; PG8_SCHED;
            PG8_LDB(B1, 0, 1); PG8_STAGE(PG8_SB(0, 0), b2, voffB);
            PG8_BAR; PG8_WAIT_L(0); PG8_MMA(0, 1, At, B1); PG8_BAR;
            PG8_LDA(At, 0, 1); PG8_STAGE(PG8_SA(0, 0), a2, voffA);
            PG8_BAR; PG8_WAIT_L(0); PG8_MMA(1, 0, At, B0); PG8_BAR; PG8_SCHED;
            PG8_STAGE(PG8_SB(0, 1), b2 + hstep, voffB);
            PG8_WAIT_V(6); PG8_BAR; PG8_MMA(1, 1, At, B1); PG8_BAR;
            PG8_LDB(B0, 1, 0); PG8_SCHED; PG8_LDA(At, 1, 0); PG8_STAGE(PG8_SA(0, 1), a2 + hstep, voffA);
            PG8_WAIT_L(8); PG8_BAR; PG8_WAIT_L(0); PG8_MMA(0, 0, At, B0); PG8_BAR; PG8_SCHED;
            PG8_LDB(B1, 1, 1); PG8_STAGE(PG8_SB(1, 0), b3, voffB);
            PG8_BAR; PG8_WAIT_L(0); PG8_MMA(0, 1, At, B1); PG8_BAR;
            PG8_LDA(At, 1, 1); PG8_STAGE(PG8_SA(1, 0), a3, voffA);
            PG8_BAR; PG8_WAIT_L(0); PG8_MMA(1, 0, At, B0); PG8_BAR; PG8_SCHED;
            PG8_STAGE(PG8_SB(1, 1), b3 + hstep, voffB);
            PG8_WAIT_V(6); PG8_BAR; PG8_MMA(1, 1, At, B1); PG8_BAR;
            }
        }
        if constexpr (ALIGN_EPI) { if (wr == 0) PG8_BAR; }
        if constexpr (!Epi::AFTER_DRAIN) { E(acc, cur, wr, wc, fr, fq); S.done(cur); }
        if (!has_next) break;
#pragma unroll
        for (int a = 0; a < 2; ++a)
#pragma unroll
            for (int b = 0; b < 2; ++b)
#pragma unroll
                for (int m = 0; m < 4; ++m)
#pragma unroll
                    for (int n = 0; n < 2; ++n) acc[a][b][m][n] = (f32x4){0.f, 0.f, 0.f, 0.f};
        cur = nxt; cA = nA; cB = nB; ++ui;
        if constexpr (ALIGN_EPI) { if (wr == 1) PG8_BAR; }
    }
    PG8_WAIT_V(0);
    if constexpr (!ALIGN_EPI) { if (wr == 0) PG8_BAR; }
    PG8_BAR;
    if constexpr (Epi::AFTER_DRAIN) { E.fused(acc, cur, wr, wc, fr, fq, lds, wid, lane); S.done(cur); }
#undef PG8_SA
#undef PG8_SB
#undef PG8_STAGE
#undef PG8_LDA
#undef PG8_LDB
#undef PG8_MMA
#undef PG8_WAIT_V
#undef PG8_WAIT_L
#undef PG8_BAR
#undef PG8_SCHED
}
}

constexpr int RING_BYTES = 131072;

__device__ __forceinline__ float wave_sum(float v) {
#pragma unroll
    for (int o = 1; o < 64; o <<= 1) v += __shfl_xor(v, o);
    return v;
}
__device__ __forceinline__ float wave_max(float v) {
#pragma unroll
    for (int o = 1; o < 64; o <<= 1) v = fmaxf(v, __shfl_xor(v, o));
    return v;
}

struct TrDesc { const float* W; const float* g; bf16_t* WT; int K, N, k0, n0; };
template <int KT> struct TrTile {
    static constexpr int RPW = KT / 8, KCW = KT / 64;
    static __device__ __forceinline__ void load(const TrDesc& d, int wave, int lane, f32x4 (&v)[RPW]) {
        const float* src = d.W + (size_t)(d.k0 + wave * RPW) * d.N + d.n0 + lane * 4;
#pragma unroll
        for (int i = 0; i < RPW; ++i) v[i] = __builtin_nontemporal_load((const f32x4*)(src + (size_t)i * d.N));
    }
    static __device__ __forceinline__ void to_lds(const TrDesc& d, LAS float* scr, int wave, int lane, f32x4 (&v)[RPW]) {
#pragma unroll
        for (int i = 0; i < RPW; ++i) { f32x4 x = v[i]; if (d.g) x = x * d.g[d.k0 + wave * RPW + i]; *(LAS f32x4*)(scr + (wave * RPW + i) * 256 + lane * 4) = x; }
    }
    static __device__ __forceinline__ void store(const TrDesc& d, const LAS float* scr, int wave, int lane) {
#pragma unroll
        for (int c = 0; c < KCW; ++c) { const int kc = wave * KCW + c;
#pragma unroll
            for (int q = 0; q < 4; ++q) { const int n = lane + 64 * q; const LAS float* t = scr + (8 * kc) * 256 + n;
                u32x4 o; o.x = cvt_pk_bf16(t[0 * 256], t[1 * 256]); o.y = cvt_pk_bf16(t[2 * 256], t[3 * 256]); o.z = cvt_pk_bf16(t[4 * 256], t[5 * 256]); o.w = cvt_pk_bf16(t[6 * 256], t[7 * 256]);
                *(u32x4*)(d.WT + (size_t)(d.n0 + n) * d.K + d.k0 + 8 * kc) = o; } }
    }
};

struct Ptrs {
    const float *x, *p, *g_mix, *w_in, *g_q, *g_k, *w_conv, *w_ao, *w_co, *w_o, *g_mlp, *w_up, *w_dn, *g_ple, *w_g, *w_pp;
    float* out; unsigned char* ws;
};

constexpr int LT_AO = (AW / 128) * (D / 256), LT_CO = (CW / 128) * (D / 256), LT_O = (D / 128) * (D / 256), LT_UP = (D / 128) * (FF / 256), LT_DN = (FF / 128) * (D / 256), LT_G = LT_O, LT_PP = (PLE / 128) * (D / 256);
constexpr int N_LATE_ITEMS = LT_AO + LT_CO + LT_O + LT_UP + LT_DN + LT_G + LT_PP;
__device__ __forceinline__ TrDesc late_desc(const Ptrs& P, int it) {
    unsigned char* ws = P.ws; int r = it; TrDesc d;
    if (r < LT_AO) { d.W = P.w_ao; d.g = nullptr; d.WT = (bf16_t*)(ws + WS_WAO); d.K = AW; d.N = D; }
    else if ((r -= LT_AO) < LT_CO) { d.W = P.w_co; d.g = nullptr; d.WT = (bf16_t*)(ws + WS_WCO); d.K = CW; d.N = D; }
    else if ((r -= LT_CO) < LT_O) { d.W = P.w_o; d.g = nullptr; d.WT = (bf16_t*)(ws + WS_WO); d.K = D; d.N = D; }
    else if ((r -= LT_O) < LT_UP) { d.W = P.w_up; d.g = P.g_mlp; d.WT = (bf16_t*)(ws + WS_WUP); d.K = D; d.N = FF; }
    else if ((r -= LT_UP) < LT_DN) { d.W = P.w_dn; d.g = nullptr; d.WT = (bf16_t*)(ws + WS_WDN); d.K = FF; d.N = D; }
    else if ((r -= LT_DN) < LT_G) { d.W = P.w_g; d.g = P.g_ple; d.WT = (bf16_t*)(ws + WS_WG); d.K = D; d.N = D; }
    else { r -= LT_G; d.W = P.w_pp; d.g = nullptr; d.WT = (bf16_t*)(ws + WS_WPP); d.K = PLE; d.N = D; }
    const int nblk = d.N >> 8, kb = r / nblk, nb = r - kb * nblk; d.k0 = kb * 128; d.n0 = nb << 8;
    return d;
}
__device__ __forceinline__ void late_weight_steal(const Ptrs& P, LAS unsigned char* lds, unsigned* ctr, int wave, int lane) {
    LAS float* scr = (LAS float*)lds;
    volatile LAS unsigned* slot = (volatile LAS unsigned*)(lds + LDS_BYTES - 32);
    const bool t0 = (wave == 0 && lane == 0);
    if (t0) slot[0] = __hip_atomic_fetch_add(ctr, 1u, __ATOMIC_RELAXED, __HIP_MEMORY_SCOPE_AGENT);
    __syncthreads();
    unsigned it = __builtin_amdgcn_readfirstlane(slot[0]);
    if (it >= (unsigned)N_LATE_ITEMS) return;
    TrDesc d = late_desc(P, (int)it);
    f32x4 v[16];
    TrTile<128>::load(d, wave, lane, v);
    for (;;) {
        __syncthreads();
        TrTile<128>::to_lds(d, scr, wave, lane, v);
        if (t0) slot[0] = __hip_atomic_fetch_add(ctr, 1u, __ATOMIC_RELAXED, __HIP_MEMORY_SCOPE_AGENT);
        __syncthreads();
        const unsigned nxt = __builtin_amdgcn_readfirstlane(slot[0]);
        const bool more = nxt < (unsigned)N_LATE_ITEMS;
        TrDesc dn = d;
        if (more) { dn = late_desc(P, (int)nxt); TrTile<128>::load(dn, wave, lane, v); }
        TrTile<128>::store(d, scr, wave, lane);
        if (!more) break;
        d = dn;
    }
    __syncthreads();
}

__device__ __forceinline__ void p0_prologue(const Ptrs& P, LAS unsigned char* lds, int vcu, int G, int wave, int lane) {
    const int gw = vcu * NWAVES + wave, NGW = G * NWAVES;
    unsigned char* ws = P.ws;
    {
        constexpr int I0 = (D / 64) * (NZ / 256), NBLK_N = NZ / 256;
        LAS float* scr = (LAS float*)lds;
        int it = vcu;
        if (it < I0) {
            TrDesc d; d.W = P.w_in; d.g = P.g_mix; d.WT = (bf16_t*)(ws + WS_WIN); d.K = D; d.N = NZ; d.k0 = (it / NBLK_N) * 64; d.n0 = (it % NBLK_N) << 8;
            f32x4 v[8];
            TrTile<64>::load(d, wave, lane, v);
            for (;;) {
                __syncthreads();
                TrTile<64>::to_lds(d, scr, wave, lane, v);
                __syncthreads();
                const int nxt = it + G; const bool more = nxt < I0;
                TrDesc dn = d;
                if (more) { dn.k0 = (nxt / NBLK_N) * 64; dn.n0 = (nxt % NBLK_N) << 8; TrTile<64>::load(dn, wave, lane, v); }
                TrTile<64>::store(d, scr, wave, lane);
                if (!more) break;
                d = dn; it = nxt;
            }
        }
    }
    bf16_t* hb = (bf16_t*)(ws + WS_HB);
    for (int m = gw; m < M; m += 2 * NGW) {
        const int m1 = (m + NGW < M) ? m + NGW : m;
        const f32x4* xr0 = (const f32x4*)(P.x + (size_t)m * D) + lane; const f32x4* xr1 = (const f32x4*)(P.x + (size_t)m1 * D) + lane;
        f32x4 v[8], w[8]; float s0 = 0.f, s1 = 0.f;
#pragma unroll
        for (int j = 0; j < 8; ++j) v[j] = __builtin_nontemporal_load(xr0 + 64 * j);
#pragma unroll
        for (int j = 0; j < 8; ++j) w[j] = __builtin_nontemporal_load(xr1 + 64 * j);
#pragma unroll
        for (int j = 0; j < 8; ++j) s0 += (v[j][0] * v[j][0] + v[j][1] * v[j][1]) + (v[j][2] * v[j][2] + v[j][3] * v[j][3]);
#pragma unroll
        for (int j = 0; j < 8; ++j) s1 += (w[j][0] * w[j][0] + w[j][1] * w[j][1]) + (w[j][2] * w[j][2] + w[j][3] * w[j][3]);
        const float r0 = __builtin_amdgcn_rsqf(wave_sum(s0) * (1.0f / D) + RMS_EPS), r1 = __builtin_amdgcn_rsqf(wave_sum(s1) * (1.0f / D) + RMS_EPS);
        u32x2* o0 = (u32x2*)(hb + (size_t)m * D) + lane; u32x2* o1 = (u32x2*)(hb + (size_t)m1 * D) + lane;
#pragma unroll
        for (int j = 0; j < 8; ++j) { u32x2 t; t.x = cvt_pk_bf16(v[j][0] * r0, v[j][1] * r0); t.y = cvt_pk_bf16(v[j][2] * r0, v[j][3] * r0); o0[64 * j] = t; }
#pragma unroll
        for (int j = 0; j < 8; ++j) { u32x2 t; t.x = cvt_pk_bf16(w[j][0] * r1, w[j][1] * r1); t.y = cvt_pk_bf16(w[j][2] * r1, w[j][3] * r1); o1[64 * j] = t; }
    }
    bf16_t* pb = (bf16_t*)(ws + WS_PB);
    for (int i = gw * 64 + lane; i < M * PLE / 8; i += NGW * 64) {
        const f32x4 a = *(const f32x4*)(P.p + (size_t)i * 8), b = *(const f32x4*)(P.p + (size_t)i * 8 + 4);
        u32x4 w; w.x = cvt_pk_bf16(a[0], a[1]); w.y = cvt_pk_bf16(a[2], a[3]); w.z = cvt_pk_bf16(b[0], b[1]); w.w = cvt_pk_bf16(b[2], b[3]);
        *(u32x4*)(pb + (size_t)i * 8) = w;
    }
}

constexpr int P2_VPITCH = 272;
constexpr int P2_RED_OFF = 256 * P2_VPITCH;
__device__ __forceinline__ void unpack8(const u32x4 w, float (&f)[8]) {
    f[0] = bf_lo(w.x); f[1] = bf_hi(w.x); f[2] = bf_lo(w.y); f[3] = bf_hi(w.y); f[4] = bf_lo(w.z); f[5] = bf_hi(w.z); f[6] = bf_lo(w.w); f[7] = bf_hi(w.w);
}
__device__ __forceinline__ u32x4 pack8(const float (&f)[8]) { u32x4 w; w.x = cvt_pk_bf16(f[0], f[1]); w.y = cvt_pk_bf16(f[2], f[3]); w.z = cvt_pk_bf16(f[4], f[5]); w.w = cvt_pk_bf16(f[6], f[7]); return w; }
__device__ __forceinline__ float sum16(float s) { s += __shfl_xor(s, 1); s += __shfl_xor(s, 2); s += __shfl_xor(s, 4); s += __shfl_xor(s, 8); return s; }

__device__ __forceinline__ void p2_unit(const Ptrs& P, LAS unsigned char* lds, int item, int tid, bf16_t* qdst, bf16_t* kdst, bf16_t* cbdst) {
    unsigned char* ws = P.ws;
    const int b = item >> 7, n = (item >> 3) & 15, h = item & 7;
    const int cch = tid & 15, rg = tid >> 4, lane = tid & 63, wave = tid >> 6;
    const int c0 = h * 128 + cch * 8;
    bf16_t* qb = (bf16_t*)(ws + WS_Q); bf16_t* kb = (bf16_t*)(ws + WS_K); const bf16_t* vb = (const bf16_t*)(ws + WS_V);
    bf16_t* cb = (bf16_t*)(ws + WS_CB); const bf16_t* cc = (const bf16_t*)(ws + WS_CC); const bf16_t* cx = (const bf16_t*)(ws + WS_CX);
    float gq[8], gk[8], w0[8], w1[8], w2[8], ksum[8];
#pragma unroll
    for (int j = 0; j < 8; ++j) { gq[j] = P.g_q[cch * 8 + j] * QSCALE; gk[j] = P.g_k[cch * 8 + j]; w0[j] = P.w_conv[c0 + j]; w1[j] = P.w_conv[CW + c0 + j]; w2[j] = P.w_conv[2 * CW + c0 + j]; ksum[j] = 0.f; }
#pragma unroll 1
    for (int i = 0; i < 8; ++i) {
        const int rl = rg + 32 * i, t = n * 256 + rl; const size_t off = (size_t)(b * SEQ + t) * 1024 + c0;
        float f[8];
        {
            unpack8(*(const u32x4*)(qb + off), f); float s = 0.f;
#pragma unroll
            for (int j = 0; j < 8; ++j) s += f[j] * f[j];
            const float rs = __builtin_amdgcn_rsqf(sum16(s) * (1.0f / HD) + RMS_EPS);
#pragma unroll
            for (int j = 0; j < 8; ++j) f[j] = f[j] * rs * gq[j];
            *(u32x4*)(qdst + off) = pack8(f);
        }
        {
            unpack8(*(const u32x4*)(kb + off), f); float s = 0.f;
#pragma unroll
            for (int j = 0; j < 8; ++j) s += f[j] * f[j];
            const float rs = __builtin_amdgcn_rsqf(sum16(s) * (1.0f / HD) + RMS_EPS);
#pragma unroll
            for (int j = 0; j < 8; ++j) { f[j] = f[j] * rs * gk[j]; ksum[j] += f[j]; }
            *(u32x4*)(kdst + off) = pack8(f);
        }
        *(LAS u32x4*)(lds + rl * P2_VPITCH + cch * 16) = *(const u32x4*)(vb + off);
        {
            float a[8], c[8], y[8];
            unpack8(*(const u32x4*)(cc + off), a); unpack8(*(const u32x4*)(cx + off), c);
#pragma unroll
            for (int j = 0; j < 8; ++j) y[j] = w2[j] * (a[j] * c[j]);
            if (t >= 1) { unpack8(*(const u32x4*)(cc + off - 1024), a); unpack8(*(const u32x4*)(cx + off - 1024), c);
#pragma unroll
                for (int j = 0; j < 8; ++j) y[j] += w1[j] * (a[j] * c[j]); }
            if (t >= 2) { unpack8(*(const u32x4*)(cc + off - 2048), a); unpack8(*(const u32x4*)(cx + off - 2048), c);
#pragma unroll
                for (int j = 0; j < 8; ++j) y[j] += w0[j] * (a[j] * c[j]); }
            unpack8(*(const u32x4*)(cb + off), a);
#pragma unroll
            for (int j = 0; j < 8; ++j) y[j] *= a[j];
            *(u32x4*)(cbdst + off) = pack8(y);
        }
    }
    LAS float* red = (LAS float*)(lds + P2_RED_OFF);
#pragma unroll
    for (int j = 0; j < 8; ++j) { float s = ksum[j]; s += __shfl_xor(s, 16); s += __shfl_xor(s, 32); if (lane < 16) red[wave * 128 + cch * 8 + j] = s; }
    __syncthreads();
    if (tid < 128) { float s = 0.f;
#pragma unroll
        for (int w = 0; w < 8; ++w) s += red[w * 128 + tid];
        ((float*)(ws + WS_KMEAN))[((size_t)((b * NH + h) * NBLK + n)) * 128 + tid] = s * (1.0f / MOBA_BLK); }
    bf16_t* vt = (bf16_t*)(ws + WS_VT) + (size_t)((b * NH + h) * 64 + n * 4) * (128 * 64);
#pragma unroll 2
    for (int i = 0; i < 8; ++i) {
        const int ch = tid + 512 * i, d = ch & 127, kc = ch >> 7;
        const int kbase = (kc >> 1) * 16 + 4 * (kc & 1);
        unsigned short e[8];
#pragma unroll
        for (int j = 0; j < 8; ++j) e[j] = *(const LAS unsigned short*)(lds + (kbase + 8 * (j >> 2) + (j & 3)) * P2_VPITCH + d * 2);
        u32x4 w; w.x = e[0] | ((unsigned)e[1] << 16); w.y = e[2] | ((unsigned)e[3] << 16); w.z = e[4] | ((unsigned)e[5] << 16); w.w = e[6] | ((unsigned)e[7] << 16);
        const int kt = kc >> 3, slot0 = (kc & 7) * 8;
        *(u32x4*)(vt + (size_t)(kt * 128 + d) * 64 + slot0) = w;
    }
    __syncthreads();
}

constexpr int AT_KBUF = 64 * 256, AT_VBUF = 128 * 128;
constexpr int AT_STAGE = AT_KBUF + AT_VBUF, AT_NSTAGE = 4;
#define MFMA32(a, b, c) __builtin_amdgcn_mfma_f32_32x32x16_bf16((a), (b), (c), 0, 0, 0)

__device__ __forceinline__ void attn_unit(const Ptrs& P, LAS unsigned char* lds, int bh, int qb, int tid, bf16_t* Obuf) {
    unsigned char* ws = P.ws;
    const int b = bh >> 3, h = bh & 7;
    const int lane = tid & 63, r32 = lane & 31, hi = lane >> 5, wid = __builtin_amdgcn_readfirstlane(tid >> 6);
    const bf16_t* Qn = (const bf16_t*)(ws + WS_Q); const bf16_t* Kn = (const bf16_t*)(ws + WS_K);
    const bf16_t* Vt = (const bf16_t*)(ws + WS_VT) + (size_t)bh * 64 * (128 * 64);
    const float* Kmean = (const float*)(ws + WS_KMEAN) + (size_t)bh * NBLK * 128;
    const size_t rowbase = (size_t)b * SEQ;
    const int qi = wid * 32 + r32;
    const size_t qrow = rowbase + qb * 256 + qi;
    const int NT = 4 * (qb + 1);

    const char* ksrc[2]; const char* vsrc[2];
#pragma unroll
    for (int i_ = 0; i_ < 2; ++i_) {
        const int pk = wid + 8 * i_, key = pk * 4 + (lane >> 4), ck = (lane & 15) ^ (key & 15);
        ksrc[i_] = (const char*)(Kn + (rowbase + key) * 1024 + h * 128 + ck * 8);
        const int pv = wid + 8 * i_, rr = pv * 8 + (lane >> 3), cv = (lane & 7) ^ ((rr >> 1) & 7);
        vsrc[i_] = (const char*)(Vt + (size_t)rr * 64 + cv * 8);
    }
#define AT_LOAD(t) do { const int st_ = (t) & (AT_NSTAGE - 1); _Pragma("unroll") for (int i_ = 0; i_ < 2; ++i_) { \
        __builtin_amdgcn_global_load_lds((const unsigned*)(ksrc[i_] + (size_t)(t) * (64 * 1024 * 2)), (LAS unsigned*)(lds + st_ * AT_STAGE + (wid + 8 * i_) * 1024), 16, 0, 0); \
        __builtin_amdgcn_global_load_lds((const unsigned*)(vsrc[i_] + (size_t)(t) * (128 * 64 * 2)), (LAS unsigned*)(lds + st_ * AT_STAGE + AT_KBUF + (wid + 8 * i_) * 1024), 16, 0, 0); } } while (0)

    bf16x8 qf[8];
#pragma unroll
    for (int d0 = 0; d0 < 8; ++d0) qf[d0] = *(const bf16x8*)(Qn + qrow * 1024 + h * 128 + d0 * 16 + hi * 8);

    float mref;
    { const float a = fabsf(P.g_q[lane] * P.g_k[lane]), c = fabsf(P.g_q[lane + 64] * P.g_k[lane + 64]); mref = wave_max(fmaxf(a, c)) * (11.313708498984761f * LOG2E); }

    unsigned selmask = 0u;
    {
        f32x16 g;
#pragma unroll
        for (int r = 0; r < 16; ++r) g[r] = 0.f;
#pragma unroll
        for (int d0 = 0; d0 < 8; ++d0) {
            u32x4 a = (u32x4){0u, 0u, 0u, 0u};
            if (r32 < 16) { const f32x4 x0 = *(const f32x4*)(Kmean + r32 * 128 + d0 * 16 + hi * 8), x1 = *(const f32x4*)(Kmean + r32 * 128 + d0 * 16 + hi * 8 + 4);
                a.x = cvt_pk_bf16(x0[0], x0[1]); a.y = cvt_pk_bf16(x0[2], x0[3]); a.z = cvt_pk_bf16(x1[0], x1[1]); a.w = cvt_pk_bf16(x1[2], x1[3]); }
            g = MFMA32(__builtin_bit_cast(bf16x8, a), qf[d0], g);
        }
        float gate[16];
#pragma unroll
        for (int r = 0; r < 8; ++r) { const float mine = g[r], other = __shfl_xor(mine, 32); const int bl = (r & 3) + 8 * (r >> 2);
            gate[bl] = hi == 0 ? mine : other; gate[bl + 4] = hi == 0 ? other : mine; }
#pragma unroll
        for (int pass = 0; pass < TOPK; ++pass) { float best = -INFINITY; int bi = -1;
#pragma unroll
            for (int nb = 0; nb < 16; ++nb) { const bool ok = (nb < qb) && !((selmask >> nb) & 1u) && (gate[nb] > best); best = ok ? gate[nb] : best; bi = ok ? nb : bi; }
            if (bi >= 0) selmask |= 1u << bi; }
    }

    f32x16 o[4];
#pragma unroll
    for (int dt = 0; dt < 4; ++dt)
#pragma unroll
        for (int r = 0; r < 16; ++r) o[dt][r] = 0.f;
    float lsum = 0.f;

    asm volatile("s_waitcnt vmcnt(0)" ::: "memory");
    AT_LOAD(0); AT_LOAD(1); AT_LOAD(2);
    const int kxs = (r32 >> 1) & 7, vxs = (r32 >> 2) & 3;
    const int koff = r32 * 256 + ((hi ^ (r32 & 1)) << 4), voff = r32 * 128 + ((hi ^ ((r32 >> 1) & 1)) << 4);
#pragma unroll 1
    for (int t = 0; t < NT; ++t) {
        if (t + 2 < NT) asm volatile("s_waitcnt vmcnt(8)" ::: "memory"); else if (t + 1 < NT) asm volatile("s_waitcnt vmcnt(4)" ::: "memory"); else asm volatile("s_waitcnt vmcnt(0)" ::: "memory");
        __builtin_amdgcn_s_barrier();
        asm volatile("" ::: "memory");
        if (t + 3 < NT) AT_LOAD(t + 3);
        const int st = t & (AT_NSTAGE - 1), n = t >> 2, kt = t & 3;
        const bool diag = (n == qb);
        const bool lane_on = diag || ((selmask >> n) & 1u);
        const LAS unsigned char* kbuf = lds + st * AT_STAGE + koff;
        const LAS unsigned char* vbuf = lds + st * AT_STAGE + AT_KBUF + voff;
        const float cinit = lane_on ? -mref : -1.0e30f;
        if (diag || __any(lane_on)) {
#pragma unroll
            for (int kh = 0; kh < 2; ++kh) {
                if (diag && (2 * kt + kh > wid)) continue;
                f32x16 s;
#pragma unroll
                for (int r = 0; r < 16; ++r) s[r] = cinit;
#pragma unroll
                for (int d0 = 0; d0 < 8; ++d0) { const bf16x8 a = *(const LAS bf16x8*)(kbuf + kh * 32 * 256 + ((d0 ^ kxs) << 5)); s = MFMA32(a, qf[d0], s); }
                if (diag) {
                    const int kbase = 64 * kt + 32 * kh + 4 * hi;
#pragma unroll
                    for (int r = 0; r < 16; ++r) { const int kidx = kbase + (r & 3) + 8 * (r >> 2); const float p = __builtin_amdgcn_exp2f(s[r]); s[r] = (kidx <= qi) ? p : 0.f; lsum += s[r]; }
                } else {
#pragma unroll
                    for (int r = 0; r < 16; ++r) { s[r] = __builtin_amdgcn_exp2f(s[r]); lsum += s[r]; }
                }
#pragma unroll
                for (int sg = 0; sg < 2; ++sg) {
                    u32x4 pw; pw.x = cvt_pk_bf16(s[8 * sg + 0], s[8 * sg + 1]); pw.y = cvt_pk_bf16(s[8 * sg + 2], s[8 * sg + 3]); pw.z = cvt_pk_bf16(s[8 * sg + 4], s[8 * sg + 5]); pw.w = cvt_pk_bf16(s[8 * sg + 6], s[8 * sg + 7]);
                    const bf16x8 pf = __builtin_bit_cast(bf16x8, pw);
#pragma unroll
                    for (int dt = 0; dt < 4; ++dt) { const bf16x8 a = *(const LAS bf16x8*)(vbuf + dt * 32 * 128 + (((kh * 2 + sg) ^ vxs) << 5)); o[dt] = MFMA32(a, pf, o[dt]); }
                }
            }
        }
    }
    lsum += __shfl_xor(lsum, 32);
    const float rl = __builtin_amdgcn_rcpf(lsum);
    bf16_t* orow = Obuf + qrow * 1024 + h * 128;
#pragma unroll
    for (int dt = 0; dt < 4; ++dt)
#pragma unroll
        for (int gq = 0; gq < 4; ++gq) { u32x2 w; w.x = cvt_pk_bf16(o[dt][4 * gq] * rl, o[dt][4 * gq + 1] * rl); w.y = cvt_pk_bf16(o[dt][4 * gq + 2] * rl, o[dt][4 * gq + 3] * rl);
            *(u32x2*)(orow + dt * 32 + 8 * gq + 4 * hi) = w; }
    __syncthreads();
#undef AT_LOAD
}


#define XB_TMO      128
#define XB_XCNT(j)  (256  + 64 * (j))
#define XB_XSUB(j)  (1280 + 64 * (j))
#define XB_XGEN(j)  (2304 + 64 * (j))
#define XB_TOP      3328
#define XB_TOPGEN   3392
#define XCD_BAR_WORDS 3456
#define XB_SPIN_CAP (1u << 18)
__device__ __forceinline__ unsigned xb_ld(unsigned* p)              { return __hip_atomic_load(p, __ATOMIC_RELAXED, __HIP_MEMORY_SCOPE_AGENT); }
__device__ __forceinline__ unsigned xb_add(unsigned* p, unsigned v) { return __hip_atomic_fetch_add(p, v, __ATOMIC_RELAXED, __HIP_MEMORY_SCOPE_AGENT); }
__device__ __forceinline__ unsigned xb_xcc_id() { return (unsigned)__builtin_amdgcn_s_getreg((3 << 11) | 20) & 0xFu; }
#define XB_SPIN(cond, bar) do { unsigned _sp = 0; while (cond) { __builtin_amdgcn_s_sleep(1); \
    if ((++_sp & 255u) == 0u) { if (xb_ld(&(bar)[XB_TMO])) break; if (_sp > XB_SPIN_CAP) { atomicAdd(&(bar)[XB_TMO], 1u); break; } } } } while (0)
struct XcdBarrier { unsigned* bar; unsigned x; volatile LAS unsigned* st; };
__device__ __forceinline__ XcdBarrier xcd_barrier_post(unsigned* bar, volatile LAS unsigned* st, int tid) {
    XcdBarrier b; b.bar = bar; b.x = xb_xcc_id(); b.st = st;
    if (tid == 0) (void)xb_add(&bar[XB_XCNT(b.x)], 1u);
    return b;
}
__device__ __forceinline__ void xcd_barrier_complete(unsigned* bar, unsigned x, unsigned& nloc, unsigned& nx) {
    const unsigned G = gridDim.x * gridDim.y * gridDim.z;
    unsigned sum, cnt, mine, sp = 0u;
    for (;;) {
        sum = 0u; cnt = 0u; mine = 0u;
#pragma unroll
        for (unsigned j = 0; j < 16; ++j) { const unsigned c = xb_ld(&bar[XB_XCNT(j)]); sum += c; cnt += (c > 0u) ? 1u : 0u; mine = (j == x) ? c : mine; }
        if (sum == G) break;
        __builtin_amdgcn_s_sleep(1);
        if ((++sp & 255u) == 0u) { if (xb_ld(&bar[XB_TMO])) break; if (sp > XB_SPIN_CAP) { atomicAdd(&bar[XB_TMO], 1u); break; } }
    }
    nloc = mine > 0u ? mine : 1u; nx = cnt > 0u ? cnt : 1u;
}
__device__ __forceinline__ void xcd_barrier(const XcdBarrier& b, const int wv) {
    asm volatile("s_waitcnt vmcnt(0)" ::: "memory");
    __syncthreads();
    if (wv == 0 && lane_id_asm() == 0) {
        unsigned* bar = b.bar;
        __builtin_amdgcn_s_waitcnt(0);
        unsigned nloc = b.st[0], nx = b.st[1];
        if (nloc == 0u) { xcd_barrier_complete(bar, b.x, nloc, nx); b.st[0] = nloc; b.st[1] = nx; }
        const unsigned old = xb_add(&bar[XB_XSUB(b.x)], 1u);
        const unsigned gen = old / nloc;
        if (old + 1u == (gen + 1u) * nloc) {
            __builtin_amdgcn_fence(__ATOMIC_RELEASE, "agent");
            asm volatile("s_waitcnt vmcnt(0)" ::: "memory");
            const unsigned og = xb_add(&bar[XB_TOP], 1u);
            const unsigned tg = og / nx;
            if (og + 1u == (tg + 1u) * nx) xb_add(&bar[XB_TOPGEN], 1u);
            else XB_SPIN(xb_ld(&bar[XB_TOPGEN]) == tg, bar);
            __builtin_amdgcn_fence(__ATOMIC_ACQUIRE, "agent");
            xb_add(&bar[XB_XGEN(b.x)], 1u);
            asm volatile("s_waitcnt vmcnt(0)" ::: "memory");
        } else {
            XB_SPIN(xb_ld(&bar[XB_XGEN(b.x)]) == gen, bar);
            __builtin_amdgcn_fence(__ATOMIC_ACQUIRE, "agent");
            asm volatile("s_waitcnt vmcnt(0)" ::: "memory");
        }
    }
    __syncthreads();
}

constexpr int NPHASES = 9;
struct Args { const float* in[16]; float* out; unsigned char* ws; int ph_lo, ph_hi; };
#ifndef PROBE_DUP
#define PROBE_DUP -1
#endif
#ifndef MK_N_LAUNCHES
#define MK_N_LAUNCHES 1
#endif

__global__ void __launch_bounds__(NTHREADS, 2) hybrid_fwd(Args args) {
    extern __shared__ __attribute__((aligned(16))) unsigned char lds_raw[];
    LAS unsigned char* lds = (LAS unsigned char*)lds_raw;
    cg::grid_group grid = cg::this_grid();
    volatile LAS unsigned* misc = (volatile LAS unsigned*)(lds + LDS_BYTES - 64);
    if (threadIdx.x < 16) misc[threadIdx.x] = 0u;
    __syncthreads();
    const int wv = __builtin_amdgcn_readfirstlane(threadIdx.x >> 6);
    XcdBarrier xbar = xcd_barrier_post((unsigned*)(args.ws + WS_CTL), misc, (int)threadIdx.x);
    if (args.ph_lo == -12345) grid.sync();
    const int G = gridDim.x, bx = blockIdx.x;
    const int vcu = (G % 8 == 0) ? (bx % 8) * (G / 8) + bx / 8 : bx;
    Ptrs P;
    P.x = args.in[0]; P.p = args.in[1]; P.g_mix = args.in[2]; P.w_in = args.in[3]; P.g_q = args.in[4]; P.g_k = args.in[5]; P.w_conv = args.in[6]; P.w_ao = args.in[7];
    P.w_co = args.in[8]; P.w_o = args.in[9]; P.g_mlp = args.in[10]; P.w_up = args.in[11]; P.w_dn = args.in[12]; P.g_ple = args.in[13]; P.w_g = args.in[14]; P.w_pp = args.in[15];
    P.out = args.out; P.ws = args.ws;
    unsigned char* ws = args.ws;
    const int lo = args.ph_lo, hi = args.ph_hi;
#define IN(k) (lo <= (k) && (k) < hi)
#define SEAM(k) do { if (IN(k) && IN((k) + 1)) { xcd_barrier(xbar, wv); if (PROBE_DUP == 9) { xcd_barrier(xbar, wv); xcd_barrier(xbar, wv); } } } while (0)
    using namespace pg8;

    if (IN(0)) { const int t0 = wv * 64 + lane_id_asm(); p0_prologue(P, lds, vcu, G, wv, t0 & 63);
        if (PROBE_DUP == 0) { __syncthreads(); p0_prologue(P, lds, vcu, G, wv, t0 & 63); } }
    SEAM(0);
    if (IN(1)) {
        Gemm g{(const bf16_t*)(ws + WS_HB), (const bf16_t*)(ws + WS_WIN), M, NZ, D}; StaticOrder S; S.init(M, NZ, G, bx);
        EpiZ E{ws};
        gemm_phase<EpiZ, StaticOrder, true, true>(lds, g, S, E, wv);
        if (PROBE_DUP == 1) gemm_phase<EpiZ, StaticOrder, true, true>(lds, g, S, E, wv);
    }
    SEAM(1);
    if (IN(2)) { const int t2 = wv * 64 + lane_id_asm(); if (PROBE_DUP == 2) { for (int it = vcu; it < BATCH * NBLK * NH; it += G) p2_unit(P, lds, it, t2, (bf16_t*)(ws + WS_WIN), (bf16_t*)(ws + WS_WIN + 16 * MiB), (bf16_t*)(ws + WS_HB)); }
        for (int it = vcu; it < BATCH * NBLK * NH; it += G) p2_unit(P, lds, it, t2, (bf16_t*)(ws + WS_Q), (bf16_t*)(ws + WS_K), (bf16_t*)(ws + WS_CB)); }
    SEAM(2);
    if (IN(3)) { const int t3 = wv * 64 + lane_id_asm(); for (int rep3 = (PROBE_DUP == 3 ? 0 : 1); rep3 < 2; ++rep3) { bf16_t* Ob = (bf16_t*)(ws + (rep3 ? WS_Q : WS_CC));
            for (int u = vcu; u < BATCH * NH * NBLK; u += G) attn_unit(P, lds, u >> 4, u & 15, t3, Ob); }
        late_weight_steal(P, lds, (unsigned*)(ws + WS_CTL) + XCD_BAR_WORDS + 64, wv, t3 & 63);
        if (PROBE_DUP == 33) late_weight_steal(P, lds, (unsigned*)(ws + WS_CTL) + XCD_BAR_WORDS + 128, wv, t3 & 63); }
    SEAM(3);
    for (int rep4 = 0; rep4 < (PROBE_DUP == 4 ? 2 : 1); ++rep4)
    if (IN(4)) {
        { Gemm g{(const bf16_t*)(ws + WS_CB), (const bf16_t*)(ws + WS_WCO), M, D, CW}; StaticOrder S; S.init(M, D, G, bx);
          EpiConvPart E{(const bf16_t*)(ws + WS_SC), (bf16_t*)(ws + WS_T1)};
          gemm_phase<EpiConvPart, StaticOrder, true, true>(lds, g, S, E, wv); }
        { Gemm g{(const bf16_t*)(ws + WS_Q), (const bf16_t*)(ws + WS_WAO), M, D, AW}; StaticOrder S; S.init(M, D, G, bx);
          EpiMerged E{(const bf16_t*)(ws + WS_SA), (const bf16_t*)(ws + WS_T1), (bf16_t*)(ws + WS_MERGED)};
          gemm_phase<EpiMerged, StaticOrder, true, true>(lds, g, S, E, wv); }
    }
    SEAM(4);
    if (IN(5)) {
        Gemm g{(const bf16_t*)(ws + WS_MERGED), (const bf16_t*)(ws + WS_WO), M, D, D}; StaticOrder S; S.init(M, D, G, bx);
        EpiResid<false> E{P.x, (bf16_t*)(ws + WS_R1B), (float*)(ws + WS_ST1)};
        gemm_phase<EpiResid<false>, StaticOrder, false, true>(lds, g, S, E, wv);
    }
    SEAM(5);
    if (IN(6)) {
        Gemm g{(const bf16_t*)(ws + WS_R1B), (const bf16_t*)(ws + WS_WUP), M, FF, D}; StaticOrder S; S.init(M, FF, G, bx);
        EpiUp E{(const float*)(ws + WS_ST1), (bf16_t*)(ws + WS_ACT)};
        gemm_phase<EpiUp, StaticOrder, true, true>(lds, g, S, E, wv);
        if (PROBE_DUP == 6) gemm_phase<EpiUp, StaticOrder, true, true>(lds, g, S, E, wv);
    }
    SEAM(6);
    if (IN(7)) {
        Gemm g{(const bf16_t*)(ws + WS_ACT), (const bf16_t*)(ws + WS_WDN), M, D, FF}; StaticOrder S; S.init(M, D, G, bx);
        EpiResid<true> E{(const bf16_t*)(ws + WS_R1B), (bf16_t*)(ws + WS_R2B), (float*)(ws + WS_ST2)};
        gemm_phase<EpiResid<true>, StaticOrder, false, true>(lds, g, S, E, wv);
    }
    SEAM(7);
    if (IN(8)) {
        { Gemm g{(const bf16_t*)(ws + WS_PB), (const bf16_t*)(ws + WS_WPP), M, D, PLE}; StaticOrder S; S.init(M, D, G, bx);
          EpiStoreBf16 E{(bf16_t*)(ws + WS_T2)};
          gemm_phase<EpiStoreBf16, StaticOrder, true, true>(lds, g, S, E, wv); }
        { Gemm g{(const bf16_t*)(ws + WS_R2B), (const bf16_t*)(ws + WS_WG), M, D, D}; StaticOrder S; S.init(M, D, G, bx);
          EpiOut E{(const float*)(ws + WS_ST2), (const bf16_t*)(ws + WS_T2), (const bf16_t*)(ws + WS_R2B), P.out};
          gemm_phase<EpiOut, StaticOrder, true, true>(lds, g, S, E, wv); }
    }
#undef IN
#undef SEAM
}

extern "C" void kernel_launch(void* const* d_in, const int* in_sizes, int n_in, void* d_out, int out_size, void* d_ws, size_t ws_size, hipStream_t stream) {
    static int grid = 0;
    if (grid == 0) {
        if (n_in != 16 || in_sizes[0] != M * D || out_size != M * D || ws_size < WS_END) { fprintf(stderr, "kernel_launch: unexpected shapes (n_in %d, in0 %d, out %d, ws %zu); nothing launched\n", n_in, n_in > 0 ? in_sizes[0] : -1, out_size, ws_size); grid = -1; return; }
        int dev = 0, cus = 0, per_cu = 0;
        if (hipGetDevice(&dev) != hipSuccess || hipDeviceGetAttribute(&cus, hipDeviceAttributeMultiprocessorCount, dev) != hipSuccess) { fprintf(stderr, "kernel_launch: device query failed\n"); grid = -1; return; }
        if (hipFuncSetAttribute((const void*)hybrid_fwd, hipFuncAttributeMaxDynamicSharedMemorySize, LDS_BYTES) != hipSuccess) { fprintf(stderr, "kernel_launch: hipFuncSetAttribute failed\n"); grid = -1; return; }
        if (hipOccupancyMaxActiveBlocksPerMultiprocessor(&per_cu, (const void*)hybrid_fwd, NTHREADS, LDS_BYTES) != hipSuccess || per_cu < 1) { fprintf(stderr, "kernel_launch: occupancy query says %d blocks per CU\n", per_cu); per_cu = 1; }
        (void)hipGetLastError();
        grid = cus * 1;
    }
    if (grid < 0) return;
    if (hipMemsetAsync((char*)d_ws + WS_CTL, 0, CTL_ZERO_BYTES, stream) != hipSuccess) { fprintf(stderr, "kernel_launch: memset of the barrier words failed\n"); return; }
    Args a{};
    for (int i = 0; i < 16; ++i) a.in[i] = (const float*)d_in[i];
    a.out = (float*)d_out; a.ws = (unsigned char*)d_ws;
    constexpr int NL = MK_N_LAUNCHES;
    for (int li = 0; li < NL; ++li) {
        a.ph_lo = (NL == 1) ? 0 : li; a.ph_hi = (NL == 1) ? NPHASES : li + 1;
        void* kargs[] = {&a};
        const hipError_t e = hipLaunchCooperativeKernel((const void*)hybrid_fwd, dim3(grid), dim3(NTHREADS), kargs, LDS_BYTES, stream);
        if (e != hipSuccess) { fprintf(stderr, "kernel_launch: cooperative launch %d failed: %s (grid %d)\n", li, hipGetErrorString(e), grid); break; }
    }
}
```
